# Optimizing an MI355X kernel written in HIP

```python
import jax
import jax.numpy as jnp
from jax import lax
import numpy as np

D_MODEL = 1024
BATCH = 2
SEQ = 8192
DEPTH = 2

PLE_DIM = 256
N_DIR = 2
RWKV_WIDTH = D_MODEL // 2
RWKV_HEAD = 64
RWKV_HEADS = RWKV_WIDTH // RWKV_HEAD
DECAY_RANK = 64
ICLR_RANK = 64
VRES_RANK = 32
ATTN_WIDTH = D_MODEL // 2
ATTN_HEAD = 64
ATTN_Q_HEADS = ATTN_WIDTH // ATTN_HEAD
ATTN_KV_HEADS = 2
ATTN_GROUP = ATTN_Q_HEADS // ATTN_KV_HEADS
KV_WIDTH = ATTN_KV_HEADS * ATTN_HEAD
WINDOW = 128
BLOCK = 128
RMS_EPS = 1e-6
GN_EPS = 64e-5
NEG_INF = -1e30

A_COLS = 4 * RWKV_WIDTH + N_DIR * (DECAY_RANK + ICLR_RANK)
B_COLS = 2 * ATTN_WIDTH + 2 * KV_WIDTH
G_COLS = 2 * D_MODEL
IN_COLS = A_COLS + B_COLS + G_COLS

kernel_name = 'hybrid_rwkv7_swa_gated_encoder'


def rms_norm(x, g):
    xf = x.astype(jnp.float32)
    y = xf * lax.rsqrt(jnp.mean(xf * xf, axis=-1, keepdims=True) + RMS_EPS)
    return (y * g.astype(jnp.float32)).astype(x.dtype)


def centred_shift(u, mu):
    zero = jnp.zeros_like(u[:, :1])
    prev = jnp.concatenate([zero, u[:, :-1]], axis=1)
    nxt = jnp.concatenate([u[:, 1:], zero], axis=1)
    return u + mu * (0.5 * (prev + nxt) - u)


def stack_dirs(t):
    return jnp.stack([t, jnp.flip(t, axis=1)])


def flip_backward(t):
    return jnp.stack([t[0], jnp.flip(t[1], axis=1)])


def wkv7_scan(r, w, k, v, a, b):
    def step(S, inp):
        r_t, w_t, k_t, v_t, a_t, b_t = inp
        sa = jnp.einsum('dbhvk,dbhk->dbhv', S, a_t)
        S = S * w_t[..., None, :] + sa[..., None] * b_t[..., None, :] + v_t[..., None] * k_t[..., None, :]
        return S, jnp.einsum('dbhvk,dbhk->dbhv', S, r_t)
    xs = tuple(jnp.moveaxis(t, 2, 0) for t in (r, w, k, v, a, b))
    n_dir, bsz, _, h, n = r.shape
    S0 = jnp.zeros((n_dir, bsz, h, n, n), jnp.float32)
    _, ys = lax.scan(step, S0, xs)
    return jnp.moveaxis(ys, 0, 2)


def rwkv7_mixer(ua, h, v_first, shift_mu, decay_w0, decay_up, iclr_a0, iclr_up,
                vres, k_k, k_a, r_k, ln_w, ln_b):
    f32 = jnp.float32
    bsz, T, _ = ua.shape
    W, H, N = RWKV_WIDTH, RWKV_HEADS, RWKV_HEAD
    ua = centred_shift(ua, shift_mu).astype(f32)
    r, k, v, z = (ua[..., j * W:(j + 1) * W] for j in range(4))
    low = ua[..., 4 * W:]
    dec_down = low[..., :N_DIR * DECAY_RANK].reshape(bsz, T, N_DIR, DECAY_RANK)
    icl_down = low[..., N_DIR * DECAY_RANK:].reshape(bsz, T, N_DIR, ICLR_RANK)
    w_raw = decay_w0.astype(f32)[:, None, None, :] + jnp.einsum('btdr,drc->dbtc', jnp.tanh(dec_down), decay_up.astype(f32))
    decay = jnp.exp(-jnp.exp(-jax.nn.softplus(-w_raw) - 0.5))
    a = jax.nn.sigmoid(iclr_a0.astype(f32)[:, None, None, :] + jnp.einsum('btdr,drc->dbtc', icl_down, iclr_up.astype(f32)))
    if vres is not None:
        vd, vu, v0 = vres
        mix = jax.nn.sigmoid(v0.astype(f32) + (h.astype(f32) @ vd.astype(f32)) @ vu.astype(f32))
        v = v + (v_first - v) * mix
    kk = (k * k_k.astype(f32)).reshape(bsz, T, H, N)
    kk = (kk / jnp.maximum(jnp.linalg.norm(kk, axis=-1, keepdims=True), 1e-12)).reshape(bsz, T, W)
    k_dir = k[None] * (1.0 + (a - 1.0) * k_a.astype(f32))
    heads = lambda t: t.reshape(t.shape[:3] + (H, N))
    y = wkv7_scan(heads(stack_dirs(r)), heads(flip_backward(decay)), heads(flip_backward(k_dir)),
                  heads(stack_dirs(v)), heads(stack_dirs(-kk)), heads(flip_backward(kk[None] * a)))
    y = flip_backward(y).sum(0)
    mean = jnp.mean(y, axis=-1, keepdims=True)
    var = jnp.mean(jnp.square(y - mean), axis=-1, keepdims=True)
    y = ((y - mean) * lax.rsqrt(var + GN_EPS)).reshape(bsz, T, W) * ln_w.astype(f32) + ln_b.astype(f32)
    rh = r.reshape(bsz, T, H, N)
    ksum = k_dir.sum(0).reshape(bsz, T, H, N)
    bonus = (jnp.sum(rh * ksum * r_k.astype(f32), axis=-1, keepdims=True) * v.reshape(bsz, T, H, N)).reshape(bsz, T, W)
    o = (y + bonus) * jax.nn.silu(z)
    return o.astype(h.dtype), v


def alibi_slopes(n_heads):
    return jnp.asarray(2.0 ** (-8.0 * np.arange(1, n_heads + 1) / n_heads), dtype=jnp.float32)


def window_attention(ub, q_g, k_g, sink):
    f32 = jnp.float32
    bsz, T, _ = ub.shape
    nb = T // BLOCK
    q = ub[..., :ATTN_WIDTH].reshape(bsz, T, ATTN_Q_HEADS, ATTN_HEAD)
    k = ub[..., ATTN_WIDTH:ATTN_WIDTH + KV_WIDTH].reshape(bsz, T, ATTN_KV_HEADS, ATTN_HEAD)
    v = ub[..., ATTN_WIDTH + KV_WIDTH:ATTN_WIDTH + 2 * KV_WIDTH].reshape(bsz, T, ATTN_KV_HEADS, ATTN_HEAD)
    z = ub[..., ATTN_WIDTH + 2 * KV_WIDTH:]
    q = rms_norm(q, q_g).astype(f32) * (ATTN_HEAD ** -0.5)
    k = rms_norm(k, k_g).astype(f32)
    v = v.astype(f32)
    qb = q.reshape(bsz, nb, BLOCK, ATTN_KV_HEADS, ATTN_GROUP, ATTN_HEAD)

    def neighbours(t):
        tp = jnp.pad(t.reshape(bsz, nb, BLOCK, ATTN_KV_HEADS, ATTN_HEAD), ((0, 0), (1, 1), (0, 0), (0, 0), (0, 0)))
        return jnp.concatenate([tp[:, :-2], tp[:, 1:-1], tp[:, 2:]], axis=2)

    kw, vw = neighbours(k), neighbours(v)
    s = jnp.einsum('bnqgrd,bnkgd->bngrqk', qb, kw)
    blk = jnp.arange(nb)[:, None]
    q_pos = blk * BLOCK + jnp.arange(BLOCK)[None, :]
    k_pos = (blk - 1) * BLOCK + jnp.arange(3 * BLOCK)[None, :]
    dist = jnp.abs(q_pos[:, :, None] - k_pos[:, None, :])
    valid = (dist <= WINDOW) & (k_pos[:, None, :] >= 0) & (k_pos[:, None, :] < T)
    slopes = alibi_slopes(ATTN_Q_HEADS).reshape(ATTN_KV_HEADS, ATTN_GROUP)
    s = s - slopes[None, None, :, :, None, None] * dist.astype(f32)[None, :, None, None]
    s = jnp.where(valid[None, :, None, None], s, NEG_INF)
    sk = sink.astype(f32).reshape(ATTN_KV_HEADS, ATTN_GROUP)[None, None, :, :, None, None]
    m = jnp.maximum(jnp.max(s, axis=-1, keepdims=True), sk)
    e = jnp.exp(s - m)
    pr = e / (jnp.sum(e, axis=-1, keepdims=True) + jnp.exp(sk - m))
    o = jnp.einsum('bngrqk,bnkgd->bnqgrd', pr, vw).reshape(bsz, T, ATTN_WIDTH)
    return o.astype(ub.dtype) * jax.nn.silu(z)


def setup_inputs(seed: int = 0) -> dict:
    key = jax.random.key(seed)
    ks = jax.random.split(key, 26)
    f32 = jnp.float32
    nrm = lambda k, shape, scale: scale * jax.random.normal(k, shape, f32)
    lin = jnp.arange(RWKV_WIDTH, dtype=f32) / (RWKV_WIDTH - 1)
    w0_base = -6.5 + 5.0 * lin ** 1.5
    nv = DEPTH - 1
    return {
        'x': nrm(ks[0], (BATCH, SEQ, D_MODEL), 1.0),
        'p': nrm(ks[1], (DEPTH, BATCH, SEQ, PLE_DIM), 1.0),
        'norm_g': 1.0 + nrm(ks[2], (DEPTH, D_MODEL), 0.05),
        'w_in': nrm(ks[3], (DEPTH, D_MODEL, IN_COLS), D_MODEL ** -0.5),
        'shift_mu': jax.random.uniform(ks[4], (DEPTH, A_COLS), f32, 0.1, 0.9),
        'decay_w0': w0_base + nrm(ks[5], (DEPTH, N_DIR, RWKV_WIDTH), 0.1),
        'decay_up': nrm(ks[6], (DEPTH, N_DIR, DECAY_RANK, RWKV_WIDTH), 0.5 * DECAY_RANK ** -0.5),
        'iclr_a0': nrm(ks[7], (DEPTH, N_DIR, RWKV_WIDTH), 0.1),
        'iclr_up': nrm(ks[8], (DEPTH, N_DIR, ICLR_RANK, RWKV_WIDTH), 0.5 * ICLR_RANK ** -0.5),
        'vres_down': nrm(ks[9], (nv, D_MODEL, VRES_RANK), D_MODEL ** -0.5),
        'vres_up': nrm(ks[10], (nv, VRES_RANK, RWKV_WIDTH), 0.5 * VRES_RANK ** -0.5),
        'vres_v0': 1.0 + nrm(ks[11], (nv, RWKV_WIDTH), 0.1),
        'k_k': 0.85 + nrm(ks[12], (DEPTH, RWKV_WIDTH), 0.02),
        'k_a': 1.0 + nrm(ks[13], (DEPTH, RWKV_WIDTH), 0.02),
        'r_k': nrm(ks[14], (DEPTH, RWKV_HEADS, RWKV_HEAD), 0.05),
        'ln_x_w': 1.0 + nrm(ks[15], (DEPTH, RWKV_WIDTH), 0.05),
        'ln_x_b': nrm(ks[16], (DEPTH, RWKV_WIDTH), 0.02),
        'q_norm_g': 1.0 + nrm(ks[17], (DEPTH, ATTN_HEAD), 0.05),
        'k_norm_g': 1.0 + nrm(ks[18], (DEPTH, ATTN_HEAD), 0.05),
        'sink': nrm(ks[19], (DEPTH, ATTN_Q_HEADS), 0.5),
        'proj_a': nrm(ks[20], (DEPTH, RWKV_WIDTH, D_MODEL), RWKV_WIDTH ** -0.5),
        'proj_b': nrm(ks[21], (DEPTH, ATTN_WIDTH, D_MODEL), ATTN_WIDTH ** -0.5),
        'w_out': nrm(ks[22], (DEPTH, D_MODEL, D_MODEL), 0.5 * D_MODEL ** -0.5),
        'ple_norm_g': 1.0 + nrm(ks[23], (DEPTH, D_MODEL), 0.05),
        'ple_gate_w': nrm(ks[24], (DEPTH, D_MODEL, D_MODEL), D_MODEL ** -0.5),
        'ple_proj': nrm(ks[25], (DEPTH, PLE_DIM, D_MODEL), PLE_DIM ** -0.5),
    }


def reference(x, p, norm_g, w_in, shift_mu, decay_w0, decay_up, iclr_a0, iclr_up,
              vres_down, vres_up, vres_v0, k_k, k_a, r_k, ln_x_w, ln_x_b,
              q_norm_g, k_norm_g, sink, proj_a, proj_b, w_out,
              ple_norm_g, ple_gate_w, ple_proj):
    v_first = None
    for i in range(DEPTH):
        h = rms_norm(x, norm_g[i])
        u = h @ w_in[i]
        ua = u[..., :A_COLS]
        ub = u[..., A_COLS:A_COLS + B_COLS]
        ug = u[..., A_COLS + B_COLS:]
        vres = None if i == 0 else (vres_down[i - 1], vres_up[i - 1], vres_v0[i - 1])
        o_a, v_a = rwkv7_mixer(ua, h, v_first, shift_mu[i], decay_w0[i], decay_up[i], iclr_a0[i],
                               iclr_up[i], vres, k_k[i], k_a[i], r_k[i], ln_x_w[i], ln_x_b[i])
        if i == 0:
            v_first = v_a
        o_b = window_attention(ub, q_norm_g[i], k_norm_g[i], sink[i])
        y_a = o_a @ proj_a[i]
        y_b = o_b @ proj_b[i]
        merged = jax.nn.sigmoid(ug[..., :D_MODEL]) * y_a + jax.nn.sigmoid(ug[..., D_MODEL:]) * y_b
        x = x + merged @ w_out[i]
        ple = p[i] @ ple_proj[i]
        x = x + jax.nn.sigmoid(rms_norm(x, ple_norm_g[i]) @ ple_gate_w[i]) * ple
    return x
```

```cpp
#include <hip/hip_runtime.h>
#include <hip/hip_cooperative_groups.h>
#include <cstdio>
#include <cstdint>
namespace cg = cooperative_groups;

#define DI __device__ __forceinline__
typedef unsigned short bf16_t;
typedef short bf16x8 __attribute__((ext_vector_type(8)));
typedef short bf16x4 __attribute__((ext_vector_type(4)));
typedef float f32x4 __attribute__((ext_vector_type(4)));
typedef unsigned u32x4 __attribute__((ext_vector_type(4)));
typedef unsigned u32x2 __attribute__((ext_vector_type(2)));


DI int otid() { int t = threadIdx.x; asm volatile("" : "+v"(t)); return t; }
DI int obid() { int b = blockIdx.x; asm volatile("" : "+s"(b)); return b; }
namespace pg8 {
#define PG8_LAS __attribute__((address_space(3)))
constexpr int BM = 256, BK = 64, HALF = 128, HTB = HALF * BK * 2, STAGE_BYTES = 8 * HTB, NXCD = 8, WGM = 8;
__host__ __device__ __forceinline__ int lds_byte(int r, int c) { const int st = (r >> 4) * 2 + (c >> 5), rr = r & 15, cc = c & 31, ob = rr * 64 + cc * 2; return st * 1024 + (ob ^ (((ob >> 9) & 1) << 5)); }
__host__ __device__ __forceinline__ void stage_rc(int b, int& R, int& C) { const int st = b / 1024, sb = b % 1024, swz = sb ^ (((sb >> 9) & 1) << 5); R = (st >> 1) * 16 + swz / 64; C = (st & 1) * 32 + (swz % 64) / 2; }
__host__ __device__ __forceinline__ int perm32(int rho) { const int n = rho >> 4, i = rho & 15; return 8 * (i >> 2) + 4 * n + (i & 3); }
struct Unit { int pm, pn; };
struct Gemm { const bf16_t* A; const bf16_t* Bt; int M, N, K; };
struct StaticOrder {
    int nM, nN, nwg, G, c;
    __host__ __device__ void init(int M, int N, int G_, int c_) { nM = M / BM; nN = N / BM; nwg = nM * nN; G = G_; c = c_; }
    __host__ __device__ bool next(int i, Unit& u) const {
        const long L = (long)i * G + c; if (L >= nwg) return false;
        int wgid = (int)L; { const int q = nwg / NXCD, r = nwg % NXCD, xcd = wgid % NXCD, off = wgid / NXCD; wgid = (xcd < r ? xcd * (q + 1) : r * (q + 1) + (xcd - r) * q) + off; }
        const int nig = WGM * nN, gid = wgid / nig, fm = gid * WGM, gsz = (nM - fm) < WGM ? (nM - fm) : WGM;
        u.pm = fm + ((wgid % nig) % gsz); u.pn = (wgid % nig) / gsz; return true;
    }
    __device__ __forceinline__ void a_ready(const Unit&) const {}
    __device__ __forceinline__ void done(const Unit&) const {}
};
__device__ __forceinline__ unsigned cvt_pk_bf16(float lo, float hi) { unsigned r; asm volatile("v_cvt_pk_bf16_f32 %0, %1, %2" : "=v"(r) : "v"(lo), "v"(hi)); return r; }
template <class Epi, class Sched, bool ALIGN_EPI = false, bool SP2 = false>
__device__ __forceinline__ void gemm_phase(PG8_LAS unsigned char* lds, const Gemm g, const Sched& S, const Epi& E) {
    const int tid = otid(), wid = __builtin_amdgcn_readfirstlane(tid >> 6), lane = tid & 63, wr = wid >> 2, wc = wid & 3, fr = lane & 15, fq = lane >> 4;
    const int K = g.K, nt = K / BK;
    unsigned voffA[2], voffB[2];
#pragma unroll
    for (int i = 0; i < 2; ++i) { int R, C; stage_rc(tid * 16 + i * 8192, R, C); const int Rb = Epi::PERM ? ((R & ~31) + perm32(R & 31)) : R;
        voffA[i] = (unsigned)(R * K + C) * 2u; voffB[i] = (unsigned)(Rb * K + C) * 2u; }
    const size_t kstep = (size_t)(BK * 2);
    const size_t hstep = (size_t)HALF * K * 2;
    const size_t tstep = 2 * hstep;
    const unsigned ldsw = (unsigned)wid * 1024u;
    const int aoff = lds_byte(wr * 64 + fr, fq * 8), boff = lds_byte(wc * 32 + fr, fq * 8);
#define PG8_SA(b, h) (((b) * 2 + (h)) * HTB)
#define PG8_SB(b, h) ((4 + (b) * 2 + (h)) * HTB)
#define PG8_STAGE(bufoff, gbase, voff) do { _Pragma("unroll") for (int _i = 0; _i < 2; ++_i) \
        __builtin_amdgcn_global_load_lds((const unsigned*)((const char*)(gbase) + (voff)[_i]), (PG8_LAS unsigned*)(lds + (bufoff) + ldsw + _i * 8192), 16, 0, 0); } while (0)
#define PG8_LDA(dst, b, h) do { _Pragma("unroll") for (int m = 0; m < 4; ++m) _Pragma("unroll") for (int k = 0; k < 2; ++k) dst[m][k] = *(const PG8_LAS bf16x8*)(lds + PG8_SA(b, h) + aoff + m * 2048 + k * 1024); } while (0)
#define PG8_LDB(dst, b, h) do { _Pragma("unroll") for (int n = 0; n < 2; ++n) _Pragma("unroll") for (int k = 0; k < 2; ++k) dst[n][k] = *(const PG8_LAS bf16x8*)(lds + PG8_SB(b, h) + boff + n * 2048 + k * 1024); } while (0)
#define PG8_MMA(ai, bj, At, Bt) do { __builtin_amdgcn_s_setprio(1); _Pragma("unroll") for (int m = 0; m < 4; ++m) _Pragma("unroll") for (int n = 0; n < 2; ++n) _Pragma("unroll") for (int k = 0; k < 2; ++k) \
        acc[ai][bj][m][n] = __builtin_amdgcn_mfma_f32_16x16x32_bf16(Bt[n][k], At[m][k], acc[ai][bj][m][n], 0, 0, 0); __builtin_amdgcn_s_setprio(0); } while (0)
#define PG8_WAIT_V(n) asm volatile("s_waitcnt vmcnt(" #n ")" ::: "memory")
#define PG8_WAIT_L(n) asm volatile("s_waitcnt lgkmcnt(" #n ")" ::: "memory")
#define PG8_BAR __builtin_amdgcn_s_barrier()
#define PG8_SCHED __builtin_amdgcn_sched_barrier(0)
    Unit cur, nxt; int ui = 0;
    if (!S.next(0, cur)) return;
    f32x4 acc[2][2][4][2];
#pragma unroll
    for (int a = 0; a < 2; ++a)
#pragma unroll
        for (int b = 0; b < 2; ++b)
#pragma unroll
            for (int m = 0; m < 4; ++m)
#pragma unroll
                for (int n = 0; n < 2; ++n) acc[a][b][m][n] = (f32x4){0.f, 0.f, 0.f, 0.f};
    bf16x8 At[4][2], B0[2][2], B1[2][2];
    const char* cA = (const char*)g.A + (size_t)cur.pm * tstep; const char* cB = (const char*)g.Bt + (size_t)cur.pn * tstep;
    S.a_ready(cur);
    if constexpr (SP2) {
        PG8_STAGE(PG8_SB(0, 0), cB, voffB); PG8_STAGE(PG8_SB(0, 1), cB + hstep, voffB); PG8_STAGE(PG8_SA(0, 0), cA, voffA); PG8_STAGE(PG8_SA(0, 1), cA + hstep, voffA);
        if (wr == 1) PG8_BAR;
        PG8_WAIT_V(2); PG8_BAR;
        PG8_STAGE(PG8_SB(1, 0), cB + kstep, voffB); PG8_STAGE(PG8_SA(1, 0), cA + kstep, voffA); PG8_STAGE(PG8_SB(1, 1), cB + hstep + kstep, voffB);
        PG8_WAIT_V(6); PG8_BAR;
    } else {
        PG8_STAGE(PG8_SB(0, 0), cB, voffB); PG8_STAGE(PG8_SA(0, 0), cA, voffA); PG8_STAGE(PG8_SB(0, 1), cB + hstep, voffB); PG8_STAGE(PG8_SA(0, 1), cA + hstep, voffA);
        if (wr == 1) PG8_BAR;
        PG8_WAIT_V(4); PG8_BAR;
        PG8_STAGE(PG8_SB(1, 0), cB + kstep, voffB); PG8_STAGE(PG8_SA(1, 0), cA + kstep, voffA); PG8_STAGE(PG8_SB(1, 1), cB + hstep + kstep, voffB);
        PG8_WAIT_V(6); PG8_BAR;
    }
    for (;;) {
        const bool has_next = S.next(ui + 1, nxt);
        const char* nA = has_next ? (const char*)g.A + (size_t)nxt.pm * tstep : cA; const char* nB = has_next ? (const char*)g.Bt + (size_t)nxt.pn * tstep : cB;
        for (int t = 0; t < nt; t += 2) {
            const bool last = (t == nt - 2);
            const char* a1 = cA + (size_t)(t + 1) * kstep;
            const char* a2 = last ? nA : cA + (size_t)(t + 2) * kstep; const char* b2 = last ? nB : cB + (size_t)(t + 2) * kstep;
            const char* a3 = a2 + kstep; const char* b3 = b2 + kstep;
            if (last && has_next) S.a_ready(nxt);
            if constexpr (SP2) {
            PG8_LDB(B0, 0, 0); PG8_LDB(B1, 0, 1); PG8_SCHED; PG8_LDA(At, 0, 0); PG8_STAGE(PG8_SA(1, 1), a1 + hstep, voffA);
            PG8_WAIT_V(8); PG8_WAIT_L(0); PG8_BAR; PG8_MMA(0, 0, At, B0); PG8_MMA(0, 1, At, B1); PG8_BAR; PG8_SCHED;
            PG8_LDA(At, 0, 1); PG8_STAGE(PG8_SB(0, 0), b2, voffB); PG8_STAGE(PG8_SB(0, 1), b2 + hstep, voffB); PG8_STAGE(PG8_SA(0, 0), a2, voffA);
            PG8_WAIT_V(8); PG8_WAIT_L(0); PG8_BAR; PG8_MMA(1, 0, At, B0); PG8_MMA(1, 1, At, B1); PG8_BAR; PG8_SCHED;
            PG8_LDB(B0, 1, 0); PG8_LDB(B1, 1, 1); PG8_SCHED; PG8_LDA(At, 1, 0); PG8_STAGE(PG8_SA(0, 1), a2 + hstep, voffA);
            PG8_WAIT_V(8); PG8_WAIT_L(0); PG8_BAR; PG8_MMA(0, 0, At, B0); PG8_MMA(0, 1, At, B1); PG8_BAR; PG8_SCHED;
            PG8_LDA(At, 1, 1); PG8_STAGE(PG8_SB(1, 0), b3, voffB); PG8_STAGE(PG8_SB(1, 1), b3 + hstep, voffB); PG8_STAGE(PG8_SA(1, 0), a3, voffA);
            PG8_WAIT_V(8); PG8_WAIT_L(0); PG8_BAR; PG8_MMA(1, 0, At, B0); PG8_MMA(1, 1, At, B1); PG8_BAR; PG8_SCHED;
            } else {
            PG8_LDB(B0, 0, 0); PG8_SCHED; PG8_LDA(At, 0, 0); PG8_STAGE(PG8_SA(1, 1), a1 + hstep, voffA);
            PG8_WAIT_L(8); PG8_BAR; PG8_WAIT_L(0); PG8_MMA(0, 0, At, B0); PG8_BAR; PG8_SCHED;
            PG8_LDB(B1, 0, 1); PG8_STAGE(PG8_SB(0, 0), b2, voffB);
            PG8_BAR; PG8_WAIT_L(0); PG8_MMA(0, 1, At, B1); PG8_BAR;
            PG8_LDA(At, 0, 1); PG8_STAGE(PG8_SA(0, 0), a2, voffA);
            PG8_BAR; PG8_WAIT_L(0); PG8_MMA(1, 0, At, B0); PG8_BAR; PG8_SCHED;
            PG8_STAGE(PG8_SB(0, 1), b2 + hstep, voffB);
            PG8_WAIT_V(6); PG8_BAR; PG8_MMA(1, 1, At, B1); PG8_BAR;
            PG8_LDB(B0, 1, 0); PG8_SCHED; PG8_LDA(At, 1, 0); PG8_STAGE(PG8_SA(0, 1), a2 + hstep, voffA);
            PG8_WAIT_L(8); PG8_BAR; PG8_WAIT_L(0); PG8_MMA(0, 0, At, B0); PG8_BAR; PG8_SCHED;
            PG8_LDB(B1, 1, 1); PG8_STAGE(PG8_SB(1, 0), b3, voffB);
            PG8_BAR; PG8_WAIT_L(0); PG8_MMA(0, 1, At, B1); PG8_BAR;
            PG8_LDA(At, 1, 1); PG8_STAGE(PG8_SA(1, 0), a3, voffA);
            PG8_BAR; PG8_WAIT_L(0); PG8_MMA(1, 0, At, B0); PG8_BAR; PG8_SCHED;
            PG8_STAGE(PG8_SB(1, 1), b3 + hstep, voffB);
            PG8_WAIT_V(6); PG8_BAR; PG8_MMA(1, 1, At, B1); PG8_BAR;
            }
        }
        if constexpr (ALIGN_EPI) { if (wr == 0) PG8_BAR; }
        bool keep = false;
        if constexpr (Epi::CHAIN) keep = E.mid(acc, cur, wr, wc, fr, fq);
        if (!keep) { if constexpr (!Epi::AFTER_DRAIN) { E(acc, cur, wr, wc, fr, fq); S.done(cur); } }
        if (!has_next) break;
        if (!keep)
#pragma unroll
        for (int a = 0; a < 2; ++a)
#pragma unroll
            for (int b = 0; b < 2; ++b)
#pragma unroll
                for (int m = 0; m < 4; ++m)
#pragma unroll
                    for (int n = 0; n < 2; ++n) acc[a][b][m][n] = (f32x4){0.f, 0.f, 0.f, 0.f};
        cur = nxt; cA = nA; cB = nB; ++ui;
        if constexpr (ALIGN_EPI) { if (wr == 1) PG8_BAR; }
    }
    PG8_WAIT_V(0);
    if constexpr (!ALIGN_EPI) { if (wr == 0) PG8_BAR; }
    PG8_BAR;
    if constexpr (Epi::AFTER_DRAIN) { E.fused(acc, cur, wr, wc, fr, fq, lds, wid, lane); S.done(cur); }
#undef PG8_SA
#undef PG8_SB
#undef PG8_STAGE
#undef PG8_LDA
#undef PG8_LDB
#undef PG8_MMA
#undef PG8_WAIT_V
#undef PG8_WAIT_L
#undef PG8_BAR
#undef PG8_SCHED
}
}

constexpr int T_ = 8192, M_ = 16384, DM = 1024, NLAYER = 2;
constexpr int UA_LD = 2816, UB_LD = 1280;
constexpr size_t MiB = 1u << 20;
constexpr size_t WS_SSQ = 0, WS_DL = 1 * MiB, WS_BAR = 20 * MiB + 768 * 1024, WS_WIN = 2 * MiB, WS_WPA = 14 * MiB, WS_WPB = 15 * MiB, WS_WOUT = 16 * MiB, WS_WGATE = 18 * MiB,
                 WS_WPLE = 20 * MiB, WS_UPT = 20 * MiB + 512 * 1024, WS_XB = 21 * MiB, WS_VF = 53 * MiB, WS_OB = 69 * MiB, WS_OA = 85 * MiB, WS_UA = 101 * MiB,
                 WS_SC = 189 * MiB, WS_UB = 189 * MiB, WS_GATES = 101 * MiB, WS_P16 = 165 * MiB, WS_MERGED = 189 * MiB, WS_PLE = 221 * MiB, WS_END = 253 * MiB;
constexpr size_t SC_AH = 0, SC_BT = 16 * MiB, SC_U0 = 32 * MiB, SC_VK = 48 * MiB;
constexpr int LDS_BYTES = 147456;

struct KArgs { const float* in[26]; float* out; unsigned char* ws; };
constexpr int PARAMS_OFF = LDS_BYTES - 256;
struct Params {
    const unsigned char* sm;
    DI unsigned long long ld(int i) const { unsigned a = (unsigned)(PARAMS_OFF + i * 8); asm volatile("" : "+v"(a)); const unsigned long long v = *(const unsigned long long*)(sm + a);
        const unsigned lo = __builtin_amdgcn_readfirstlane((unsigned)v), hi = __builtin_amdgcn_readfirstlane((unsigned)(v >> 32)); return ((unsigned long long)hi << 32) | lo; }
    DI const float* in(int i) const { return (const float*)(__attribute__((address_space(1))) const float*)ld(i); }
    DI float* out() const { return (float*)(__attribute__((address_space(1))) float*)ld(26); }
    DI unsigned char* scb(int b) const { return b ? (unsigned char*)out() : ws() + WS_SC; }
    DI unsigned char* ws() const { return (unsigned char*)(__attribute__((address_space(1))) unsigned char*)ld(27); }
};
enum { I_X = 0, I_P, I_NORMG, I_WIN, I_MU, I_W0, I_DUP, I_A0, I_IUP, I_VD, I_VU, I_V0, I_KK, I_KA, I_RK, I_LNW, I_LNB, I_QG, I_KG, I_SINK, I_PA, I_PB, I_WOUT, I_PLEG, I_PLEW, I_PLEP };

typedef float f32x2_t __attribute__((ext_vector_type(2)));
typedef __bf16 bf16x2_t __attribute__((ext_vector_type(2)));
DI unsigned pk2(float lo, float hi) { const f32x2_t v = {lo, hi}; const bf16x2_t b = __builtin_convertvector(v, bf16x2_t); return __builtin_bit_cast(unsigned, b); }
DI unsigned short f2bf(float f) { return (unsigned short)(pk2(f, 0.f) & 0xffffu); }
DI float bf2f(unsigned short h) { return __uint_as_float(((unsigned)h) << 16); }
DI float bflo(unsigned w) { return __uint_as_float(w << 16); }
DI float bfhi(unsigned w) { return __uint_as_float(w & 0xffff0000u); }
DI float sigm(float x) { return __builtin_amdgcn_rcpf(1.f + __expf(-x)); }
DI void wave_sum8(float (&v)[8]) {
    const int lane = __lane_id();
    const bool h32 = lane & 32, h16 = lane & 16, h8 = lane & 8;
    float a[4], b2[2], c1;
#pragma unroll
    for (int i = 0; i < 4; ++i) { const float send = h32 ? v[i] : v[4 + i], keep = h32 ? v[4 + i] : v[i]; a[i] = keep + __shfl_xor(send, 32); }
#pragma unroll
    for (int i = 0; i < 2; ++i) { const float send = h16 ? a[i] : a[2 + i], keep = h16 ? a[2 + i] : a[i]; b2[i] = keep + __shfl_xor(send, 16); }
    { const float send = h8 ? b2[0] : b2[1], keep = h8 ? b2[1] : b2[0]; c1 = keep + __shfl_xor(send, 8); }
    c1 += __shfl_xor(c1, 4); c1 += __shfl_xor(c1, 2); c1 += __shfl_xor(c1, 1);
#pragma unroll
    for (int e = 0; e < 8; ++e) v[e] = __int_as_float(__builtin_amdgcn_readlane(__float_as_int(c1), ((e >> 2) & 1) * 32 + ((e >> 1) & 1) * 16 + (e & 1) * 8));
}
DI float wave_sum(float v) {
#pragma unroll
    for (int o = 32; o; o >>= 1) v += __shfl_xor(v, o);
    return v;
}
#define MFMA16(a, b, c) __builtin_amdgcn_mfma_f32_16x16x32_bf16((a), (b), (c), 0, 0, 0)

enum { EP_U = 0, EP_GATE, EP_PA, EP_PB, EP_PLE, EP_OUT, EP_FIN, EP_PAB };
template <int MODE> struct Epi {
    static constexpr bool PERM = true, AFTER_DRAIN = false, CHAIN = (MODE == EP_PAB);
    const float* ssq;
    bf16_t* o0; bf16_t* o1;
    const bf16_t* g;
    const float* xres; float* xout; float* ssq_out;
    DI bool mid(f32x4 (&acc)[2][2][4][2], const pg8::Unit& u, int wr, int wc, int fr, int fq) const {
        if (u.pn >= 4) return false;
        const int row0 = (u.pm - 64) * 256 + wr * 64 + fr, colb = u.pn * 256 + wc * 32 + 8 * fq;
#pragma unroll
        for (int ai = 0; ai < 2; ++ai)
#pragma unroll
            for (int m = 0; m < 4; ++m)
#pragma unroll
                for (int bj = 0; bj < 2; ++bj) {
                    const size_t o = (size_t)(row0 + ai * 128 + m * 16) * 2048 + colb + bj * 128;
                    const u32x4 ga = *(const u32x4*)(g + o), gb = *(const u32x4*)(g + o + 1024);
                    const float ra[8] = {bflo(ga.x), bfhi(ga.x), bflo(ga.y), bfhi(ga.y), bflo(ga.z), bfhi(ga.z), bflo(ga.w), bfhi(ga.w)};
                    const float rb[8] = {bflo(gb.x), bfhi(gb.x), bflo(gb.y), bfhi(gb.y), bflo(gb.z), bfhi(gb.z), bflo(gb.w), bfhi(gb.w)};
#pragma unroll
                    for (int e = 0; e < 4; ++e) { acc[ai][bj][m][0][e] *= ra[e] * __builtin_amdgcn_rcpf(rb[e]); acc[ai][bj][m][1][e] *= ra[4 + e] * __builtin_amdgcn_rcpf(rb[4 + e]); }
                }
        return true;
    }
    DI void operator()(const f32x4 (&acc)[2][2][4][2], const pg8::Unit& u0, int wr, int wc, int fr, int fq) const {
        pg8::Unit u = u0; if (MODE == EP_PAB) u.pn -= 4;
        const int row0 = u.pm * 256 + wr * 64 + fr, colb = u.pn * 256 + wc * 32 + 8 * fq;
#pragma unroll
        for (int ai = 0; ai < 2; ++ai)
#pragma unroll
            for (int m = 0; m < 4; ++m) {
                const int row = row0 + ai * 128 + m * 16;
                float rs = 1.f;
                if (MODE == EP_U || MODE == EP_GATE) rs = rsqrtf(ssq[(size_t)row * 16] * (1.0f / 1024.0f) + 1e-6f);
                if (MODE == EP_FIN) {
                    const f32x4* sp = (const f32x4*)(ssq + (size_t)row * 16);
                    f32x4 a = sp[0], b = sp[1], c = sp[2], d = sp[3];
                    float s = ((a[0] + a[1]) + (a[2] + a[3])) + ((b[0] + b[1]) + (b[2] + b[3])) + ((c[0] + c[1]) + (c[2] + c[3])) + ((d[0] + d[1]) + (d[2] + d[3]));
                    rs = rsqrtf(s * (1.0f / 1024.0f) + 1e-6f);
                }
                float sq = 0.f;
#pragma unroll
                for (int bj = 0; bj < 2; ++bj) {
                    const int col = colb + bj * 128;
                    float v[8];
#pragma unroll
                    for (int e = 0; e < 4; ++e) { v[e] = acc[ai][bj][m][0][e] * rs; v[4 + e] = acc[ai][bj][m][1][e] * rs; }
                    if (MODE == EP_U) {
                        bf16_t* dst;
                        if (u.pn < 9) dst = o0 + (size_t)row * UA_LD + col;
                        else if (u.pn < 14) dst = o1 + (size_t)row * UB_LD + (col - 2304);
                        else dst = o0 + (size_t)row * UA_LD + 2304 + (col - 3584);
                        u32x4 w; w.x = pk2(v[0], v[1]); w.y = pk2(v[2], v[3]); w.z = pk2(v[4], v[5]); w.w = pk2(v[6], v[7]);
                        *(u32x4*)dst = w;
                    } else if (MODE == EP_GATE) {
                        u32x4 w; w.x = pk2(sigm(v[0]), sigm(v[1])); w.y = pk2(sigm(v[2]), sigm(v[3])); w.z = pk2(sigm(v[4]), sigm(v[5])); w.w = pk2(sigm(v[6]), sigm(v[7]));
                        *(u32x4*)(o0 + (size_t)row * 2048 + col) = w;
                    } else if (MODE == EP_PA || MODE == EP_PB) {
                        const u32x4 gw = *(const u32x4*)(g + (size_t)row * 2048 + (MODE == EP_PB ? 1024 : 0) + col);
                        float gg[8] = {bflo(gw.x), bfhi(gw.x), bflo(gw.y), bfhi(gw.y), bflo(gw.z), bfhi(gw.z), bflo(gw.w), bfhi(gw.w)};
                        bf16_t* dst = o0 + (size_t)row * 1024 + col;
                        float o[8];
                        if (MODE == EP_PB) { const u32x4 ow = *(const u32x4*)dst; o[0] = bflo(ow.x); o[1] = bfhi(ow.x); o[2] = bflo(ow.y); o[3] = bfhi(ow.y); o[4] = bflo(ow.z); o[5] = bfhi(ow.z); o[6] = bflo(ow.w); o[7] = bfhi(ow.w); }
                        else { for (int e = 0; e < 8; ++e) o[e] = 0.f; }
#pragma unroll
                        for (int e = 0; e < 8; ++e) o[e] += gg[e] * v[e];
                        u32x4 w; w.x = pk2(o[0], o[1]); w.y = pk2(o[2], o[3]); w.z = pk2(o[4], o[5]); w.w = pk2(o[6], o[7]);
                        *(u32x4*)dst = w;
                    } else if (MODE == EP_PAB) {
                        const u32x4 gw = *(const u32x4*)(g + (size_t)row * 2048 + 1024 + col);
                        const float gg[8] = {bflo(gw.x), bfhi(gw.x), bflo(gw.y), bfhi(gw.y), bflo(gw.z), bfhi(gw.z), bflo(gw.w), bfhi(gw.w)};
                        u32x4 w; w.x = pk2(gg[0] * v[0], gg[1] * v[1]); w.y = pk2(gg[2] * v[2], gg[3] * v[3]); w.z = pk2(gg[4] * v[4], gg[5] * v[5]); w.w = pk2(gg[6] * v[6], gg[7] * v[7]);
                        *(u32x4*)(o0 + (size_t)row * 1024 + col) = w;
                    } else if (MODE == EP_PLE) {
                        u32x4 w; w.x = pk2(v[0], v[1]); w.y = pk2(v[2], v[3]); w.z = pk2(v[4], v[5]); w.w = pk2(v[6], v[7]);
                        *(u32x4*)(o0 + (size_t)row * 1024 + col) = w;
                    } else if (MODE == EP_OUT) {
                        float o[8];
                        if (xres) {
                            const f32x4 x0 = *(const f32x4*)(xres + (size_t)row * 1024 + col), x1 = *(const f32x4*)(xres + (size_t)row * 1024 + col + 4);
#pragma unroll
                            for (int e = 0; e < 4; ++e) { o[e] = x0[e] + v[e]; o[4 + e] = x1[e] + v[4 + e]; }
                        } else {
                            const u32x4 xw = *(const u32x4*)(o0 + (size_t)row * 1024 + col);
                            o[0] = bflo(xw.x) + v[0]; o[1] = bfhi(xw.x) + v[1]; o[2] = bflo(xw.y) + v[2]; o[3] = bfhi(xw.y) + v[3];
                            o[4] = bflo(xw.z) + v[4]; o[5] = bfhi(xw.z) + v[5]; o[6] = bflo(xw.w) + v[6]; o[7] = bfhi(xw.w) + v[7];
                        }
#pragma unroll
                        for (int e = 0; e < 8; ++e) sq += o[e] * o[e];
                        u32x4 w; w.x = pk2(o[0], o[1]); w.y = pk2(o[2], o[3]); w.z = pk2(o[4], o[5]); w.w = pk2(o[6], o[7]);
                        *(u32x4*)(o0 + (size_t)row * 1024 + col) = w;
                    } else if (MODE == EP_FIN) {
                        const u32x4 xw = *(const u32x4*)(o0 + (size_t)row * 1024 + col);
                        const f32x4 x0 = (f32x4){bflo(xw.x), bfhi(xw.x), bflo(xw.y), bfhi(xw.y)}, x1 = (f32x4){bflo(xw.z), bfhi(xw.z), bflo(xw.w), bfhi(xw.w)};
                        const u32x4 pw = *(const u32x4*)(g + (size_t)row * 1024 + col);
                        float pp[8] = {bflo(pw.x), bfhi(pw.x), bflo(pw.y), bfhi(pw.y), bflo(pw.z), bfhi(pw.z), bflo(pw.w), bfhi(pw.w)};
                        float o[8];
#pragma unroll
                        for (int e = 0; e < 4; ++e) { o[e] = x0[e] + sigm(v[e]) * pp[e]; o[4 + e] = x1[e] + sigm(v[4 + e]) * pp[4 + e]; }
                        *(f32x4*)(xout + (size_t)row * 1024 + col) = (f32x4){o[0], o[1], o[2], o[3]};
                        *(f32x4*)(xout + (size_t)row * 1024 + col + 4) = (f32x4){o[4], o[5], o[6], o[7]};
                    }
                }
                if (MODE == EP_OUT) {
                    sq += __shfl_xor(sq, 16); sq += __shfl_xor(sq, 32);
                    if (fq == 0) ssq_out[(size_t)row * 16 + u.pn * 4 + wc] = sq;
                }
            }
    }
};

struct PairOrder {
    pg8::StaticOrder so;
    DI void init(int G, int c) { so.init(M_, 1024, G, c); }
    DI bool next(int i, pg8::Unit& u) const { pg8::Unit t; if (!so.next(i >> 1, t)) return false; if (i & 1) { u.pm = t.pm; u.pn = t.pn + 4; } else { u.pm = t.pm + 64; u.pn = t.pn; } return true; }
    DI void a_ready(const pg8::Unit&) const {}
    DI void done(const pg8::Unit&) const {}
};
DI void run_gemm_pair(unsigned char* smem, const bf16_t* Astk, const bf16_t* Bstk, const Epi<EP_PAB>& E) {
    int N = 2048, K = 512;
    asm volatile("" : "+s"(N), "+s"(K));
    pg8::Gemm g{Astk, Bstk, 2 * M_, N, K}; PairOrder S; S.init((int)gridDim.x, obid());
    pg8::gemm_phase<Epi<EP_PAB>, PairOrder, true, true>((PG8_LAS unsigned char*)smem, g, S, E);
    __syncthreads();
}
template <int MODE> DI void run_gemm(unsigned char* smem, const bf16_t* A, const bf16_t* Bt, int N, int K, const Epi<MODE>& E) {
    if (MODE != EP_U && MODE != EP_GATE) asm volatile("" : "+s"(N), "+s"(K));
    pg8::Gemm g{A, Bt, M_, N, K}; pg8::StaticOrder S; S.init(M_, N, (int)gridDim.x, (int)obid());
    pg8::gemm_phase<Epi<MODE>, pg8::StaticOrder, true, true>((PG8_LAS unsigned char*)smem, g, S, E);
    __syncthreads();
}

DI void transpose_job(const float* src, int lds_, const float* g, bf16_t* dst, int ldd, int K, int N, float* sm, int& rot) {
    const int tid = otid(), nk = K >> 6, nn = N >> 8, nt = nk * nn, G = gridDim.x;
    int first = obid() - rot; if (first < 0) first += G;
    rot = (rot + nt) % G;
    for (int t = first; t < nt; t += G) {
        const int k0 = (t % nk) << 6, n0 = (t / nk) << 8;
        f32x4 v8[8]; float g8[8];
#pragma unroll
        for (int i = 0; i < 8; ++i) {
            const int idx = tid + 512 * i, k = idx >> 6, n4 = (idx & 63) * 4;
            v8[i] = *(const f32x4*)(src + (size_t)(k0 + k) * lds_ + n0 + n4);
            g8[i] = g ? g[k0 + k] : 1.f;
        }
#pragma unroll
        for (int i = 0; i < 8; ++i) {
            const int idx = tid + 512 * i, k = idx >> 6, n4 = (idx & 63) * 4;
            const f32x4 v = v8[i] * g8[i];
            float* o = sm + k * 257 + n4; o[0] = v[0]; o[1] = v[1]; o[2] = v[2]; o[3] = v[3];
        }
        __syncthreads();
#pragma unroll
        for (int i = 0; i < 4; ++i) {
            const int idx = tid + 512 * i, n = idx >> 3, kc = (idx & 7) * 8;
            const float* p = sm + kc * 257 + n;
            u32x4 w; w.x = pk2(p[0], p[257]); w.y = pk2(p[2 * 257], p[3 * 257]); w.z = pk2(p[4 * 257], p[5 * 257]); w.w = pk2(p[6 * 257], p[7 * 257]);
            *(u32x4*)(dst + (size_t)(n0 + n) * ldd + k0 + kc) = w;
        }
        __syncthreads();
    }
}
DI void p0_phase(const Params& P, int l, unsigned char* smem, const float* xsrc) {
    unsigned char* ws = P.ws(); float* sm = (float*)smem; int rot = 0;
    const float* ng = P.in(I_NORMG) + l * 1024;
    const float* win = P.in(I_WIN) + (size_t)l * 1024 * 5632;
    bf16_t* WIN = (bf16_t*)(ws + WS_WIN);
    transpose_job(win, 5632, ng, WIN, 1024, 1024, 3584, sm, rot);
    transpose_job(win + 3584, 5632, ng, WIN + (size_t)4096 * 1024, 1024, 1024, 2048, sm, rot);
    transpose_job(P.in(I_PA) + (size_t)l * 512 * 1024, 1024, nullptr, (bf16_t*)(ws + WS_WPA), 512, 512, 1024, sm, rot);
    transpose_job(P.in(I_PB) + (size_t)l * 512 * 1024, 1024, nullptr, (bf16_t*)(ws + WS_WPB), 512, 512, 1024, sm, rot);
    transpose_job(P.in(I_WOUT) + (size_t)l * 1024 * 1024, 1024, nullptr, (bf16_t*)(ws + WS_WOUT), 1024, 1024, 1024, sm, rot);
    transpose_job(P.in(I_PLEW) + (size_t)l * 1024 * 1024, 1024, P.in(I_PLEG) + l * 1024, (bf16_t*)(ws + WS_WGATE), 1024, 1024, 1024, sm, rot);
    transpose_job(P.in(I_PLEP) + (size_t)l * 256 * 1024, 1024, nullptr, (bf16_t*)(ws + WS_WPLE), 256, 256, 1024, sm, rot);
    for (int d = 0; d < 2; ++d) {
        transpose_job(P.in(I_DUP) + (size_t)(l * 2 + d) * 64 * 512, 512, nullptr, (bf16_t*)(ws + WS_UPT) + (size_t)d * 512 * 64, 64, 64, 512, sm, rot);
        transpose_job(P.in(I_IUP) + (size_t)(l * 2 + d) * 64 * 512, 512, nullptr, (bf16_t*)(ws + WS_UPT) + (size_t)(2 + d) * 512 * 64, 64, 64, 512, sm, rot);
    }
    if (l > 0) {
        const float* vd = P.in(I_VD) + (size_t)(l - 1) * 1024 * 32; const float* vu = P.in(I_VU) + (size_t)(l - 1) * 32 * 512;
        for (int idx = obid() * 512 + otid(); idx < 512 * 1024; idx += gridDim.x * 512) {
            const int n = idx >> 10, k = idx & 1023; float s = 0.f;
#pragma unroll 8
            for (int r = 0; r < 32; ++r) s += vd[k * 32 + r] * vu[r * 512 + n];
            WIN[(size_t)(3584 + n) * 1024 + k] = f2bf(s * ng[k]);
        }
    }
    {
        const int wave = otid() >> 6, lane = otid() & 63;
        bf16_t* XB = (bf16_t*)(ws + WS_XB); float* ssq = (float*)(ws + WS_SSQ);
        for (int row0 = (obid() * 8 + wave) * 4; row0 < M_; row0 += gridDim.x * 32) {
            f32x4 v[4][4];
#pragma unroll
            for (int i = 0; i < 4; ++i)
#pragma unroll
                for (int j = 0; j < 4; ++j) v[i][j] = *(const f32x4*)(xsrc + (size_t)(row0 + i) * 1024 + j * 256 + lane * 4);
#pragma unroll
            for (int i = 0; i < 4; ++i) {
                float s = 0.f;
#pragma unroll
                for (int j = 0; j < 4; ++j) {
                    const f32x4 x = v[i][j];
                    s += x[0] * x[0] + x[1] * x[1] + x[2] * x[2] + x[3] * x[3];
                    u32x2 w; w.x = pk2(x[0], x[1]); w.y = pk2(x[2], x[3]);
                    *(u32x2*)(XB + (size_t)(row0 + i) * 1024 + j * 256 + lane * 4) = w;
                }
                s = wave_sum(s);
                if (lane < 16) ssq[(size_t)(row0 + i) * 16 + lane] = (lane == 0) ? s : 0.f;
            }
        }
    }
}
DI void p16_phase(const Params& P, int l) {
    const float* src = P.in(I_P) + (size_t)l * M_ * 256; bf16_t* dst = (bf16_t*)(P.ws() + WS_P16);
    const unsigned n4 = (unsigned)(M_ * 256 / 4), stride = gridDim.x * 512u;
    for (unsigned i = (unsigned)obid() * 512u + (unsigned)otid(); i < n4; i += stride * 8u) {
        f32x4 v[8];
#pragma unroll
        for (int k = 0; k < 8; ++k) { const unsigned j = i + (unsigned)k * stride; v[k] = *(const f32x4*)(src + (size_t)(j < n4 ? j : n4 - 1u) * 4); }
#pragma unroll
        for (int k = 0; k < 8; ++k) { const unsigned j = i + (unsigned)k * stride; if (j < n4) { u32x2 w; w.x = pk2(v[k][0], v[k][1]); w.y = pk2(v[k][2], v[k][3]); *(u32x2*)(dst + (size_t)j * 4) = w; } }
    }
}

constexpr int AK_LD = 72, AV_LD = 456;
DI void attn_phase(const Params& P, int l, unsigned char* smem) {
    const bf16_t* UB = (const bf16_t*)(P.ws() + WS_UB); bf16_t* OB = (bf16_t*)(P.ws() + WS_OB);
    bf16_t* Ks = (bf16_t*)smem;
    bf16_t* Vt = (bf16_t*)(smem + 448 * AK_LD * 2);
    const int tid = otid(), lane = tid & 63, w = tid >> 6, r = lane & 15, q = lane >> 4;
    const float* qg = P.in(I_QG) + l * 64; const float* kg = P.in(I_KG) + l * 64;
    const float LOG2E = 1.4426950408889634f;
    for (int unit = obid(); unit < 256; unit += gridDim.x) {
        const int b = unit >> 7, g = (unit >> 6) & 1, qb = unit & 63;
        const int t0 = qb * 128, kstart = t0 - 128;
        const bf16_t* ub = UB + (size_t)b * T_ * UB_LD;
        __syncthreads();
        {
            const int seg = tid & 7;
            float kgl[8];
#pragma unroll
            for (int e = 0; e < 8; ++e) kgl[e] = kg[seg * 8 + e];
            for (int it = 0; it < 7; ++it) {
                const int key = (tid >> 3) + 64 * it, tok = kstart + key;
                u32x4 kw = (u32x4){0u, 0u, 0u, 0u}, vw = (u32x4){0u, 0u, 0u, 0u};
                { const bool ok = (key < 384 && tok >= 0 && tok < T_); const int tcl = tok < 0 ? 0 : (tok >= T_ ? T_ - 1 : tok);
                  const u32x4 k_ = *(const u32x4*)(ub + (size_t)tcl * UB_LD + 512 + g * 64 + seg * 8), v_ = *(const u32x4*)(ub + (size_t)tcl * UB_LD + 640 + g * 64 + seg * 8);
                  if (ok) { kw = k_; vw = v_; } }
                float kf[8] = {bflo(kw.x), bfhi(kw.x), bflo(kw.y), bfhi(kw.y), bflo(kw.z), bfhi(kw.z), bflo(kw.w), bfhi(kw.w)};
                float ss = 0.f;
#pragma unroll
                for (int e = 0; e < 8; ++e) ss += kf[e] * kf[e];
                ss += __shfl_xor(ss, 1); ss += __shfl_xor(ss, 2); ss += __shfl_xor(ss, 4);
                const float rs = rsqrtf(ss * (1.0f / 64.0f) + 1e-6f);
                u32x4 o; o.x = pk2(kf[0] * rs * kgl[0], kf[1] * rs * kgl[1]); o.y = pk2(kf[2] * rs * kgl[2], kf[3] * rs * kgl[3]);
                o.z = pk2(kf[4] * rs * kgl[4], kf[5] * rs * kgl[5]); o.w = pk2(kf[6] * rs * kgl[6], kf[7] * rs * kgl[7]);
                *(u32x4*)(Ks + key * AK_LD + seg * 8) = o;
                const unsigned vv[4] = {vw.x, vw.y, vw.z, vw.w};
#pragma unroll
                for (int e = 0; e < 4; ++e) { const int ks_ = key ^ (seg << 2);
                    Vt[(seg * 8 + 2 * e) * AV_LD + ks_] = (bf16_t)(vv[e] & 0xffffu); Vt[(seg * 8 + 2 * e + 1) * AV_LD + ks_] = (bf16_t)(vv[e] >> 16); }
            }
        }
        __syncthreads();
        const int hh = w >> 1, head = g * 4 + hh;
        const float slope2 = exp2f(-(float)(head + 1)) * LOG2E;
        const float sink2 = P.in(I_SINK)[l * 8 + head] * LOG2E;
#pragma unroll
        for (int qh = 0; qh < 2; ++qh) {
        const int qoff = (w & 1) * 64 + qh * 32, q0 = t0 + qoff;
        bf16x8 Qf[2][2];
#pragma unroll
        for (int qt = 0; qt < 2; ++qt) {
            const bf16_t* qp = ub + (size_t)(q0 + qt * 16 + r) * UB_LD + head * 64;
            float qv[16]; float ss = 0.f;
#pragma unroll
            for (int ks = 0; ks < 2; ++ks) {
                const u32x4 qw = *(const u32x4*)(qp + ks * 32 + q * 8);
                qv[ks * 8 + 0] = bflo(qw.x); qv[ks * 8 + 1] = bfhi(qw.x); qv[ks * 8 + 2] = bflo(qw.y); qv[ks * 8 + 3] = bfhi(qw.y);
                qv[ks * 8 + 4] = bflo(qw.z); qv[ks * 8 + 5] = bfhi(qw.z); qv[ks * 8 + 6] = bflo(qw.w); qv[ks * 8 + 7] = bfhi(qw.w);
            }
#pragma unroll
            for (int e = 0; e < 16; ++e) ss += qv[e] * qv[e];
            ss += __shfl_xor(ss, 16); ss += __shfl_xor(ss, 32);
            const float rs = rsqrtf(ss * (1.0f / 64.0f) + 1e-6f) * 0.125f * LOG2E;
#pragma unroll
            for (int ks = 0; ks < 2; ++ks) {
                u32x4 o;
                const float* gq = qg + ks * 32 + q * 8;
                o.x = pk2(qv[ks * 8 + 0] * rs * gq[0], qv[ks * 8 + 1] * rs * gq[1]); o.y = pk2(qv[ks * 8 + 2] * rs * gq[2], qv[ks * 8 + 3] * rs * gq[3]);
                o.z = pk2(qv[ks * 8 + 4] * rs * gq[4], qv[ks * 8 + 5] * rs * gq[5]); o.w = pk2(qv[ks * 8 + 6] * rs * gq[6], qv[ks * 8 + 7] * rs * gq[7]);
                Qf[qt][ks] = __builtin_bit_cast(bf16x8, o);
            }
        }
        f32x4 O[4][2];
        float mrun[2], lrun[2];
#pragma unroll
        for (int qt = 0; qt < 2; ++qt) { mrun[qt] = sink2; lrun[qt] = (q == 0) ? 1.f : 0.f;
#pragma unroll
            for (int dt = 0; dt < 4; ++dt) O[dt][qt] = (f32x4){0.f, 0.f, 0.f, 0.f}; }
        for (int kb = 0; kb < 5; ++kb) {
            const int kl0 = qoff + kb * 64;
            f32x4 S[4][2];
            {
                bf16x8 kf[4][2];
#pragma unroll
                for (int kt = 0; kt < 4; ++kt) { kf[kt][0] = *(const bf16x8*)(Ks + (kl0 + kt * 16 + r) * AK_LD + q * 8); kf[kt][1] = *(const bf16x8*)(Ks + (kl0 + kt * 16 + r) * AK_LD + 32 + q * 8); }
                __builtin_amdgcn_sched_barrier(0);
#pragma unroll
                for (int kt = 0; kt < 4; ++kt)
#pragma unroll
                    for (int qt = 0; qt < 2; ++qt) { f32x4 a = (f32x4){0.f, 0.f, 0.f, 0.f}; a = MFMA16(kf[kt][0], Qf[qt][0], a); a = MFMA16(kf[kt][1], Qf[qt][1], a); S[kt][qt] = a; }
            }
            bf16x8 vfr[2][4];
#pragma unroll
            for (int ps = 0; ps < 2; ++ps)
#pragma unroll
                for (int dt = 0; dt < 4; ++dt) {
                    const bf16_t* vp = Vt + (dt * 16 + r) * AV_LD + kl0 + ps * 32; const int gsw = ((2 * dt + (r >> 3)) & 7) << 2;
                    const u32x2 v0 = *(const u32x2*)(vp + ((4 * q) ^ gsw)), v1 = *(const u32x2*)(vp + ((4 * q + 16) ^ gsw));
                    u32x4 vv; vv.x = v0.x; vv.y = v0.y; vv.z = v1.x; vv.w = v1.y;
                    vfr[ps][dt] = __builtin_bit_cast(bf16x8, vv);
                }
            __builtin_amdgcn_sched_barrier(0);
#pragma unroll
            for (int qt = 0; qt < 2; ++qt) {
                const int qpos = q0 + qt * 16 + r;
                float mx = -3.0e38f;
#pragma unroll
                for (int kt = 0; kt < 4; ++kt)
#pragma unroll
                    for (int j = 0; j < 4; ++j) {
                        const int kpos = kstart + kl0 + kt * 16 + 4 * q + j; int dist = qpos - kpos; dist = dist < 0 ? -dist : dist;
                        const bool valid = (dist <= 128) && (kpos >= 0) && (kpos < T_);
                        const float s = valid ? (S[kt][qt][j] - slope2 * (float)dist) : -1.0e30f;
                        S[kt][qt][j] = s; mx = fmaxf(mx, s);
                    }
                mx = fmaxf(mx, __shfl_xor(mx, 16)); mx = fmaxf(mx, __shfl_xor(mx, 32));
                const float mn = fmaxf(mrun[qt], mx), alpha = __builtin_amdgcn_exp2f(mrun[qt] - mn);
                mrun[qt] = mn; float ps = 0.f;
#pragma unroll
                for (int kt = 0; kt < 4; ++kt)
#pragma unroll
                    for (int j = 0; j < 4; ++j) { const float p = __builtin_amdgcn_exp2f(S[kt][qt][j] - mn); S[kt][qt][j] = p; ps += p; }
                lrun[qt] = lrun[qt] * alpha + ps;
#pragma unroll
                for (int dt = 0; dt < 4; ++dt) O[dt][qt] = O[dt][qt] * alpha;
            }
#pragma unroll
            for (int ps = 0; ps < 2; ++ps) {
                bf16x8 Pf[2];
#pragma unroll
                for (int qt = 0; qt < 2; ++qt) {
                    u32x4 o; o.x = pk2(S[2 * ps][qt][0], S[2 * ps][qt][1]); o.y = pk2(S[2 * ps][qt][2], S[2 * ps][qt][3]);
                    o.z = pk2(S[2 * ps + 1][qt][0], S[2 * ps + 1][qt][1]); o.w = pk2(S[2 * ps + 1][qt][2], S[2 * ps + 1][qt][3]);
                    Pf[qt] = __builtin_bit_cast(bf16x8, o);
                }
#pragma unroll
                for (int dt = 0; dt < 4; ++dt)
#pragma unroll
                    for (int qt = 0; qt < 2; ++qt) O[dt][qt] = MFMA16(vfr[ps][dt], Pf[qt], O[dt][qt]);
            }
        }
#pragma unroll
        for (int qt = 0; qt < 2; ++qt) {
            float lt = lrun[qt]; lt += __shfl_xor(lt, 16); lt += __shfl_xor(lt, 32);
            const float inv = 1.f / lt;
            const size_t row = (size_t)b * T_ + q0 + qt * 16 + r;
#pragma unroll
            for (int dt = 0; dt < 4; ++dt) {
                const int col = head * 64 + dt * 16 + 4 * q;
                const u32x2 zw = *(const u32x2*)(UB + row * UB_LD + 768 + col);
                const float z[4] = {bflo(zw.x), bfhi(zw.x), bflo(zw.y), bfhi(zw.y)};
                float o[4];
#pragma unroll
                for (int j = 0; j < 4; ++j) o[j] = O[dt][qt][j] * inv * (z[j] * sigm(z[j]));
                u32x2 ow; ow.x = pk2(o[0], o[1]); ow.y = pk2(o[2], o[3]);
                *(u32x2*)(OB + row * 512 + col) = ow;
            }
        }
        }
    }
    __syncthreads();
}

constexpr int LP = 72;
constexpr int OFF_DD = 0, OFF_ID = 9216, OFF_WR = 18432, OFF_AR = 35072, OFF_R = 51712, OFF_A = 60928, OFF_B = 70144, OFF_K = 79360, OFF_AT = 88576, OFF_KT = 97792, OFF_VT = 107008,
              OFF_GS = 116224, OFF_YS = 118272;
constexpr int OFF_P = 0, OFF_PT = 9216, OFF_T = 18432, OFF_MAK = 27648;
struct FE { float r[8], k[8], v[8], z[8], kk[8]; };

DI float ldbf(const bf16_t* base, unsigned byteoff) { return bf2f(*(const bf16_t*)((const unsigned char*)base + byteoff)); }
DI void load_shift8(const bf16_t* base, int t0, int col, float mu, float (&out)[8]) {
    float u[10];
    const int tlo = t0 > 0 ? t0 - 1 : 0, thi = t0 + 8 < T_ ? t0 + 8 : T_ - 1;
    const unsigned o0 = ((unsigned)t0 * UA_LD + (unsigned)col) * 2u;
    u[0] = ldbf(base, ((unsigned)tlo * UA_LD + (unsigned)col) * 2u); u[9] = ldbf(base, ((unsigned)thi * UA_LD + (unsigned)col) * 2u);
#pragma unroll
    for (int e = 0; e < 8; ++e) u[e + 1] = ldbf(base, o0 + (unsigned)e * (UA_LD * 2u));
    u[0] = t0 > 0 ? u[0] : 0.f; u[9] = t0 + 8 < T_ ? u[9] : 0.f;
#pragma unroll
    for (int e = 0; e < 8; ++e) out[e] = u[e + 1] + mu * (0.5f * (u[e] + u[e + 2]) - u[e + 1]);
}
DI f32x4 mm_tile_gs(const bf16_t* A, int lda, const bf16_t* Bt, int mt, int nt, int r, int q, f32x4 acc) {
#pragma unroll
    for (int ks = 0; ks < 2; ++ks) {
        const int row = nt * 16 + r;
        const bf16x8 a = *(const bf16x8*)(A + (mt * 16 + r) * lda + ks * 32 + q * 8);
        const bf16x8 b = *(const bf16x8*)(Bt + row * 64 + (((4 * ks + q) ^ ((row >> 1) & 7)) * 8));
        acc = MFMA16(a, b, acc);
    }
    return acc;
}
DI f32x4 mm_tile(const bf16_t* A, int lda, const bf16_t* Bt, int ldb, int mt, int nt, int r, int q, f32x4 acc) {
#pragma unroll
    for (int ks = 0; ks < 2; ++ks) {
        const bf16x8 a = *(const bf16x8*)(A + (mt * 16 + r) * lda + ks * 32 + q * 8);
        const bf16x8 b = *(const bf16x8*)(Bt + (nt * 16 + r) * ldb + ks * 32 + q * 8);
        acc = MFMA16(a, b, acc);
    }
    return acc;
}
#define LBAR() do { asm volatile("s_waitcnt lgkmcnt(0)" ::: "memory"); __builtin_amdgcn_s_barrier(); asm volatile("" ::: "memory"); } while (0)
struct FED { unsigned dd[4], id[4]; };
struct Frag2 { bf16x8 k0, k1; };
DI Frag2 ldf(const bf16_t* M, int ld, int tile, int r, int q) { Frag2 f; const bf16_t* p = M + (tile * 16 + r) * ld + q * 8; f.k0 = *(const bf16x8*)p; f.k1 = *(const bf16x8*)(p + 32); return f; }
DI Frag2 ldf_gs(const bf16_t* M, int tile, int r, int q) {
    Frag2 f; const int row = tile * 16 + r; const bf16_t* p = M + row * 64; const int sw = (row >> 1) & 7;
    f.k0 = *(const bf16x8*)(p + ((q ^ sw) * 8)); f.k1 = *(const bf16x8*)(p + (((4 + q) ^ sw) * 8)); return f; }
DI f32x4 mmf(const Frag2& a, const Frag2& b, f32x4 acc) { acc = MFMA16(a.k0, b.k0, acc); return MFMA16(a.k1, b.k1, acc); }
#define SCHED_FENCE() __builtin_amdgcn_sched_barrier(0)
#define Z4 ((f32x4){0.f, 0.f, 0.f, 0.f})
DI void fe_dir_load(const Params& P, int l, int b, int tc, int d, FED& o) {
    const int c = otid() & 63, g = __builtin_amdgcn_readfirstlane(otid() >> 6), t0 = tc * 64 + 8 * g;
    const bf16_t* ua = (const bf16_t*)(P.ws() + WS_UA) + (size_t)b * T_ * UA_LD;
    const float* mu = P.in(I_MU) + l * 2304;
    const int cd = 2048 + d * 64 + c, ci = 2048 + 128 + d * 64 + c;
    float td[8], ti[8];
    load_shift8(ua, t0, cd, mu[cd], td); load_shift8(ua, t0, ci, mu[ci], ti);
#pragma unroll
    for (int e = 0; e < 4; ++e) { o.dd[e] = pk2(2.f * sigm(2.f * td[2 * e]) - 1.f, 2.f * sigm(2.f * td[2 * e + 1]) - 1.f); o.id[e] = pk2(ti[2 * e], ti[2 * e + 1]); }
}
DI void fe_shared(const Params& P, int l, int b, int h, int tc, FE& f) {
    const int c = otid() & 63, g = __builtin_amdgcn_readfirstlane(otid() >> 6), t0 = tc * 64 + 8 * g, ch = h * 64 + c;
    const bf16_t* ua = (const bf16_t*)(P.ws() + WS_UA) + (size_t)b * T_ * UA_LD;
    const float* mu = P.in(I_MU) + l * 2304;
    load_shift8(ua, t0, ch, mu[ch], f.r); load_shift8(ua, t0, 512 + ch, mu[512 + ch], f.k);
    load_shift8(ua, t0, 1024 + ch, mu[1024 + ch], f.v); load_shift8(ua, t0, 1536 + ch, mu[1536 + ch], f.z);
    if (l > 0) {
        const float v0 = P.in(I_V0)[(l - 1) * 512 + ch]; const bf16_t* VF = (const bf16_t*)(P.ws() + WS_VF);
#pragma unroll
        for (int e = 0; e < 8; ++e) {
            const int tok = t0 + e; const float mix = sigm(v0 + ldbf(ua, ((unsigned)tok * UA_LD + 2304u + (unsigned)ch) * 2u));
            const float vf = ldbf(VF, (((unsigned)b * T_ + (unsigned)tok) * 512u + (unsigned)ch) * 2u); f.v[e] += (vf - f.v[e]) * mix;
        }
    }
    const float kkc = P.in(I_KK)[l * 512 + ch];
#pragma unroll
    for (int e = 0; e < 8; ++e) f.kk[e] = f.k[e] * kkc;
    {
        float ss[8];
#pragma unroll
        for (int e = 0; e < 8; ++e) ss[e] = f.kk[e] * f.kk[e];
        wave_sum8(ss);
#pragma unroll
        for (int e = 0; e < 8; ++e) f.kk[e] *= rsqrtf(fmaxf(ss[e], 1e-24f));
    }
}
constexpr int OFF_DLS = 144128;
DI void fe_dir(const Params& P, int l, int b, int h, int tc, int d, const FE& f, const FED& fd, float (&ksum)[8], unsigned char* smem, bool store_s2, u32x4& btw) {
    const int tid = otid(), c = tid & 63, g = __builtin_amdgcn_readfirstlane(tid >> 6), ch = h * 64 + c, r = c & 15, q = c >> 4;
    bf16_t* DDs = (bf16_t*)(smem + OFF_DD); bf16_t* IDs = (bf16_t*)(smem + OFF_ID); float* WRs = (float*)(smem + OFF_WR); float* ARs = (float*)(smem + OFF_AR);
    bf16_t* Rs = (bf16_t*)(smem + OFF_R); bf16_t* As = (bf16_t*)(smem + OFF_A); bf16_t* Bs = (bf16_t*)(smem + OFF_B); bf16_t* Ks = (bf16_t*)(smem + OFF_K);
    bf16_t* ATs = (bf16_t*)(smem + OFF_AT); bf16_t* KTs = (bf16_t*)(smem + OFF_KT); bf16_t* VTs = (bf16_t*)(smem + OFF_VT); float* GS = (float*)(smem + OFF_GS);
    const float w0 = P.in(I_W0)[(l * 2 + d) * 512 + ch], a0 = P.in(I_A0)[(l * 2 + d) * 512 + ch], ka = P.in(I_KA)[l * 512 + ch];
    bf16x8 bfr[4][2];
    {
        const bf16_t* upT = (const bf16_t*)(P.ws() + WS_UPT);
#pragma unroll
        for (int e = 0; e < 4; ++e) {
            const int ti = g * 4 + e, which = ti >> 4, nt = ti & 3;
            const bf16_t* Bt = upT + (size_t)(which * 2 + d) * 512 * 64 + (size_t)(h * 64) * 64;
#pragma unroll
            for (int ks = 0; ks < 2; ++ks) bfr[e][ks] = *(const bf16x8*)(Bt + (nt * 16 + r) * 64 + ks * 32 + q * 8);
        }
    }
#pragma unroll
    for (int e = 0; e < 4; ++e) { DDs[(8 * g + 2 * e) * LP + c] = (bf16_t)(fd.dd[e] & 0xffffu); DDs[(8 * g + 2 * e + 1) * LP + c] = (bf16_t)(fd.dd[e] >> 16);
                                  IDs[(8 * g + 2 * e) * LP + c] = (bf16_t)(fd.id[e] & 0xffffu); IDs[(8 * g + 2 * e + 1) * LP + c] = (bf16_t)(fd.id[e] >> 16); }
    LBAR();
    {
        const int which = g >> 2, mt = g & 3;
        const Frag2 a = ldf(which ? IDs : DDs, LP, mt, r, q);
        float* O = which ? ARs : WRs;
#pragma unroll
        for (int e = 0; e < 4; ++e) {
            f32x4 acc = MFMA16(a.k0, bfr[e][0], Z4); acc = MFMA16(a.k1, bfr[e][1], acc);
#pragma unroll
            for (int j = 0; j < 4; ++j) O[(mt * 16 + 4 * q + j) * 65 + e * 16 + r] = acc[j];
        }
    }
    LBAR();
    float lw[8], av[8], cl[8];
#pragma unroll
    for (int e = 0; e < 8; ++e) {
        const int i = 8 * g + e; const float x = -(w0 + WRs[i * 65 + c]);
        const float sp = fmaxf(x, 0.f) + __logf(1.f + __expf(-fabsf(x)));
        lw[e] = -__expf(-sp - 0.5f); av[e] = sigm(a0 + ARs[i * 65 + c]);
    }
    float s = 0.f;
    if (d == 0) {
#pragma unroll
        for (int e = 0; e < 8; ++e) { s += lw[e]; cl[e] = s; }
    } else {
#pragma unroll
        for (int e = 7; e >= 0; --e) { s += lw[e]; cl[e] = s; }
    }
    GS[g * 64 + c] = s;
    LBAR();
    float off = 0.f, tot = 0.f;
#pragma unroll
    for (int gg = 0; gg < 8; ++gg) { const float x = GS[gg * 64 + c]; tot += x; if (d == 0 ? (gg < g) : (gg > g)) off += x; }
    const int pstart = d ? (56 - 8 * g) : 8 * g;
    unsigned pa[4], pb[4], pk[4], pv[4];
#pragma unroll
    for (int e2 = 0; e2 < 4; ++e2) {
        float Av2[2], Bv2[2], Kv2[2];
#pragma unroll
        for (int u = 0; u < 2; ++u) {
            const int e = 2 * e2 + u;
            const float cs = off + cl[e];
            const float ecs = store_s2 ? 0.f : __expf(cs), encs = __expf(-cs), eprev = store_s2 ? __expf(cs - lw[e]) : 0.f;
            const float kd = f.k[e] * (1.f + (av[e] - 1.f) * ka), bd = f.kk[e] * av[e];
            const float Rv = f.r[e] * ecs, Av = -f.kk[e] * eprev, Bv = bd * encs, Kv = kd * encs;
            const int p = d ? 63 - (8 * g + e) : 8 * g + e;
            if (!store_s2) Rs[p * LP + c] = f2bf(Rv); else As[p * LP + c] = f2bf(Av);
            Bs[p * LP + c] = f2bf(Bv); Ks[p * LP + c] = f2bf(Kv);
            ksum[e] += kd;
            Av2[u] = Av; Bv2[u] = Bv; Kv2[u] = Kv;
        }
        { const unsigned wa = pk2(Av2[0], Av2[1]), wb = pk2(Bv2[0], Bv2[1]), wk = pk2(Kv2[0], Kv2[1]), wv = pk2(f.v[2 * e2], f.v[2 * e2 + 1]);
          pa[e2] = d ? __builtin_amdgcn_alignbit(wa, wa, 16) : wa; pb[e2] = d ? __builtin_amdgcn_alignbit(wb, wb, 16) : wb;
          pk[e2] = d ? __builtin_amdgcn_alignbit(wk, wk, 16) : wk; pv[e2] = d ? __builtin_amdgcn_alignbit(wv, wv, 16) : wv; }
    }
    {
        u32x4 w;
        if (store_s2) {
        w.x = d ? pa[3] : pa[0]; w.y = d ? pa[2] : pa[1]; w.z = d ? pa[1] : pa[2]; w.w = d ? pa[0] : pa[3]; *(u32x4*)(ATs + c * LP + pstart) = w;
        w.x = d ? pk[3] : pk[0]; w.y = d ? pk[2] : pk[1]; w.z = d ? pk[1] : pk[2]; w.w = d ? pk[0] : pk[3]; *(u32x4*)(KTs + c * LP + pstart) = w;
        }
        w.x = d ? pv[3] : pv[0]; w.y = d ? pv[2] : pv[1]; w.z = d ? pv[1] : pv[2]; w.w = d ? pv[0] : pv[3]; *(u32x4*)(VTs + c * LP + pstart) = w;
        if (store_s2) {
            btw.x = d ? pb[3] : pb[0]; btw.y = d ? pb[2] : pb[1]; btw.z = d ? pb[1] : pb[2]; btw.w = d ? pb[0] : pb[3];
            if (g == 0) ((float*)(smem + OFF_DLS))[c] = __expf(tot);
        }
    }
    LBAR();
}
DI void tile_out(const bf16_t* src, bf16_t* dst) { const int t = otid(), row = t >> 3, seg = t & 7; *(u32x4*)(dst + row * 64 + ((seg ^ ((row >> 1) & 7)) * 8)) = *(const u32x4*)(src + row * LP + seg * 8); }

DI void s1_phase(const Params& P, int l, unsigned char* smem) {
    const int tid = otid(), lane = tid & 63, w = __builtin_amdgcn_readfirstlane(tid >> 6), r = lane & 15, q = lane >> 4;
    bf16_t* Rs = (bf16_t*)(smem + OFF_R); bf16_t* As = (bf16_t*)(smem + OFF_A); bf16_t* Bs = (bf16_t*)(smem + OFF_B); bf16_t* Ks = (bf16_t*)(smem + OFF_K);
    bf16_t* ATs = (bf16_t*)(smem + OFF_AT); bf16_t* KTs = (bf16_t*)(smem + OFF_KT); bf16_t* VTs = (bf16_t*)(smem + OFF_VT);
    bf16_t* MAKs = (bf16_t*)(smem + OFF_MAK);
    bf16_t* PB[2] = {(bf16_t*)(smem + OFF_P), (bf16_t*)(smem + OFF_YS)};
    bf16_t* PTB[2] = {(bf16_t*)(smem + OFF_PT), Rs};
    bf16_t* TB_[2] = {(bf16_t*)(smem + OFF_T), (bf16_t*)(smem + OFF_GS + 16640 + 2048)};
    for (int item = obid(); item < 2048; item += gridDim.x) {
        const int h = (item >> 3) & 7, tci = (item & 7) + 8 * ((item >> 6) & 3) + 32 * (item >> 8), tc = tci & 127, b = tci >> 7;
        FE f; FED fd0, fd1; float ksum[8];
#pragma unroll
        for (int e = 0; e < 8; ++e) ksum[e] = 0.f;
        fe_dir_load(P, l, b, tc, 0, fd0); fe_dir_load(P, l, b, tc, 1, fd1);
        fe_shared(P, l, b, h, tc, f);
#pragma unroll
        for (int d = 0; d < 2; ++d) {
        FED fd;
#pragma unroll
        for (int e = 0; e < 4; ++e) { fd.dd[e] = fd0.dd[e]; fd.id[e] = fd0.id[e]; }
        u32x4 btw;
        fe_dir(P, l, b, h, tc, d, f, fd, ksum, smem, true, btw);
        const int which = w >> 2, mtw = w & 3;
        f32x4 macc[4];
        {
            const Frag2 a = ldf(As, LP, mtw, r, q); Frag2 bb[4];
#pragma unroll
            for (int e = 0; e < 4; ++e) bb[e] = ldf(which ? Ks : Bs, LP, e, r, q);
            SCHED_FENCE();
#pragma unroll
            for (int e = 0; e < 4; ++e) macc[e] = mmf(a, bb[e], Z4);
        }
#pragma unroll
        for (int e = 0; e < 4; ++e) {
            const int mt = mtw, nt = e; const f32x4 acc = macc[e];
#pragma unroll
            for (int j = 0; j < 4; ++j) {
                const int m = mt * 16 + 4 * q + j, n = nt * 16 + r; const float v = (n < m) ? acc[j] : 0.f;
                if (which) MAKs[m * LP + n] = f2bf(v);
                else { const bf16_t hv = f2bf(v); PB[0][m * LP + n] = hv; PTB[0][n * LP + m] = hv; TB_[0][m * LP + n] = f2bf(v + (m == n ? 1.f : 0.f)); }
            }
        }
        LBAR();
        const int mt2 = w >> 1, nt2 = (w & 1) * 2;
#define WRITE_P(SET, PN) do { _Pragma("unroll") for (int e = 0; e < 2; ++e) { const int nt = nt2 + e; \
            _Pragma("unroll") for (int j = 0; j < 4; ++j) PB[SET][(mt2 * 16 + 4 * q + j) * LP + nt * 16 + r] = f2bf(PN[e][j]); \
            u32x2 t2; t2.x = pk2(PN[e][0], PN[e][1]); t2.y = pk2(PN[e][2], PN[e][3]); *(u32x2*)(PTB[SET] + (nt * 16 + r) * LP + mt2 * 16 + 4 * q) = t2; } } while (0)
#define WRITE_T(SET, TN) do { _Pragma("unroll") for (int e = 0; e < 2; ++e) { _Pragma("unroll") for (int j = 0; j < 4; ++j) TB_[SET][(mt2 * 16 + 4 * q + j) * LP + (nt2 + e) * 16 + r] = f2bf(TN[e][j]); } } while (0)
        {
            f32x4 pn2[2];
            { const Frag2 a = ldf(PB[0], LP, mt2, r, q), b0 = ldf(PTB[0], LP, nt2, r, q), b1 = ldf(PTB[0], LP, nt2 + 1, r, q);
              SCHED_FENCE();
              pn2[0] = mmf(a, b0, Z4); pn2[1] = mmf(a, b1, Z4); }
            WRITE_P(1, pn2);
        }
        LBAR();
#pragma unroll
        for (int it = 1; it <= 5; ++it) {
            const int pc = it & 1, tc = (it - 1) & 1;
            f32x4 pn2[2], tn2[2];
            { const Frag2 ap = ldf(PB[pc], LP, mt2, r, q), at = ldf(TB_[tc], LP, mt2, r, q), b0 = ldf(PTB[pc], LP, nt2, r, q), b1 = ldf(PTB[pc], LP, nt2 + 1, r, q);
              f32x4 i0, i1;
#pragma unroll
              for (int j = 0; j < 4; ++j) { i0[j] = bf2f(TB_[tc][(mt2 * 16 + 4 * q + j) * LP + nt2 * 16 + r]); i1[j] = bf2f(TB_[tc][(mt2 * 16 + 4 * q + j) * LP + (nt2 + 1) * 16 + r]); }
              SCHED_FENCE();
              tn2[0] = mmf(at, b0, i0); tn2[1] = mmf(at, b1, i1);
              if (it < 5) { pn2[0] = mmf(ap, b0, Z4); pn2[1] = mmf(ap, b1, Z4); } }
            if (it < 5) WRITE_P(pc ^ 1, pn2);
            WRITE_T(tc ^ 1, tn2);
            LBAR();
        }
#undef WRITE_P
#undef WRITE_T
        bf16_t* Ts = TB_[1];
        bf16_t* XTs = (bf16_t*)(smem + OFF_P);
        bf16_t* BTs = (bf16_t*)(smem + OFF_PT); bf16_t* AHTs = (bf16_t*)(smem + OFF_T);
        bf16_t* OUTA = Bs; bf16_t* OUTU = As; bf16_t* OUTV = Ks; bf16_t* OUTC = ATs;
        const float* DLs = (const float*)(smem + OFF_DLS);
        { const int c = lane, pstart = d ? (56 - 8 * w) : 8 * w; *(u32x4*)(BTs + c * LP + pstart) = btw; }
        f32x4 xo2[2], ah2[2], vk2[2];
        { const Frag2 av = ldf(VTs, LP, mt2, r, q), at = ldf(Ts, LP, mt2, r, q);
          Frag2 bm[2], ba[2], bk[2];
#pragma unroll
          for (int e = 0; e < 2; ++e) { bm[e] = ldf(MAKs, LP, nt2 + e, r, q); ba[e] = ldf(ATs, LP, nt2 + e, r, q); bk[e] = ldf(KTs, LP, nt2 + e, r, q); }
          SCHED_FENCE();
#pragma unroll
          for (int e = 0; e < 2; ++e) { xo2[e] = mmf(av, bm[e], Z4); ah2[e] = mmf(at, ba[e], Z4); vk2[e] = mmf(av, bk[e], Z4); } }
#pragma unroll
        for (int e = 0; e < 2; ++e) { const int mt = mt2, nt = nt2 + e; const f32x4 x = xo2[e], ah = ah2[e], vk = vk2[e];
#pragma unroll
            for (int j = 0; j < 4; ++j) { const int o = (mt * 16 + 4 * q + j) * LP + nt * 16 + r; XTs[o] = f2bf(x[j]); OUTA[o] = f2bf(ah[j]); OUTV[o] = f2bf(vk[j]); }
            u32x2 t2; t2.x = pk2(ah[0], ah[1]); t2.y = pk2(ah[2], ah[3]); *(u32x2*)(AHTs + (nt * 16 + r) * LP + mt * 16 + 4 * q) = t2; }
        LBAR();
        f32x4 u02[2];
        { const Frag2 a = ldf(XTs, LP, mt2, r, q), b0 = ldf(Ts, LP, nt2, r, q), b1 = ldf(Ts, LP, nt2 + 1, r, q);
          SCHED_FENCE();
          u02[0] = mmf(a, b0, Z4); u02[1] = mmf(a, b1, Z4); }
#pragma unroll
        for (int e = 0; e < 2; ++e) { const int mt = mt2, nt = nt2 + e; const f32x4 u0 = u02[e];
#pragma unroll
            for (int j = 0; j < 4; ++j) OUTU[(mt * 16 + 4 * q + j) * LP + nt * 16 + r] = f2bf(u0[j]); }
        LBAR();
        f32x4 ac2[2], bc2[2]; float dlc2[2], dlm[4];
        { const Frag2 a1 = ldf(BTs, LP, mt2, r, q), a2 = ldf(OUTU, LP, mt2, r, q);
          Frag2 b1[2], b2[2]; f32x4 vk0[2];
#pragma unroll
          for (int e = 0; e < 2; ++e) { b1[e] = ldf(AHTs, LP, nt2 + e, r, q); b2[e] = ldf(BTs, LP, nt2 + e, r, q); dlc2[e] = DLs[(nt2 + e) * 16 + r];
#pragma unroll
              for (int j = 0; j < 4; ++j) vk0[e][j] = bf2f(OUTV[(mt2 * 16 + 4 * q + j) * LP + (nt2 + e) * 16 + r]); }
#pragma unroll
          for (int j = 0; j < 4; ++j) dlm[j] = DLs[mt2 * 16 + 4 * q + j];
          SCHED_FENCE();
#pragma unroll
          for (int e = 0; e < 2; ++e) { ac2[e] = mmf(a1, b1[e], Z4); bc2[e] = mmf(a2, b2[e], vk0[e]); } }
#pragma unroll
        for (int e = 0; e < 2; ++e) { const int mt = mt2, nt = nt2 + e; const f32x4 ac = ac2[e], bc = bc2[e];
            const float dlc = dlc2[e];
#pragma unroll
            for (int j = 0; j < 4; ++j) { const int m = mt * 16 + 4 * q + j, n = nt * 16 + r;
                OUTC[m * LP + n] = f2bf((ac[j] + (m == n ? 1.f : 0.f)) * dlm[j]); OUTV[m * LP + n] = f2bf(bc[j] * dlc); } }
        LBAR();
        {
            const int dh = d * 8 + h, pc = d ? 127 - tc : tc; const size_t base = ((size_t)(dh * 128 + pc)) * 4096;
            unsigned char* sc = P.scb(b); tile_out(OUTA, (bf16_t*)(sc + SC_AH) + base); tile_out(OUTU, (bf16_t*)(sc + SC_U0) + base);
            tile_out(OUTC, (bf16_t*)(sc + SC_BT) + base); tile_out(OUTV, (bf16_t*)(sc + SC_VK) + base);
        }
        LBAR();
#pragma unroll
        for (int e = 0; e < 4; ++e) { fd0.dd[e] = fd1.dd[e]; fd0.id[e] = fd1.id[e]; }
        }
    }
}

constexpr int S2_SLOT = 10240, S2_NS = 12, S2_D = 8, S2_G = 4;
DI bf16x8 mk8(u32x2 lo, u32x2 hi) { u32x4 v; v.x = lo.x; v.y = lo.y; v.z = hi.x; v.w = hi.y; return __builtin_bit_cast(bf16x8, v); }
DI void s2_issue(const unsigned char* sc, int dh, int vg, int pc, int w, int lane, unsigned char* smem) {
    const size_t cb = ((size_t)(dh * 128 + pc)) * 8192;
    PG8_LAS unsigned char* slot = (PG8_LAS unsigned char*)smem + (pc % S2_NS) * S2_SLOT;
#pragma unroll
    for (int i = 0; i < 2; ++i) {
        const int piece = 2 * (w - 1) + i;
        const unsigned char* g = (piece < 8) ? sc + SC_BT + cb + piece * 1024 : sc + SC_VK + cb + vg * 2048 + (piece - 8) * 1024;
        __builtin_amdgcn_global_load_lds((const unsigned*)(g + lane * 16), (PG8_LAS unsigned*)(slot + piece * 1024), 16, 0, 0);
    }
}
DI void s2_phase(const Params& P, unsigned char* smem) {
    if (obid() >= 128) return;
    const int bid = obid(), tid = otid(), bdh = (bid & 7) + 8 * (bid >> 5), b = bdh >> 4, dh = bdh & 15, vg = (bid >> 3) & 3,     lane = tid & 63, r = lane & 15, q = lane >> 4, w = __builtin_amdgcn_readfirstlane(tid >> 6);
    unsigned char* sc = P.scb(b);
    const bool loader = (w >= 1 && w <= 5);
    __syncthreads();
    if (loader) {
        for (int c = 0; c < S2_D; ++c) s2_issue(sc, dh, vg, c, w, lane, smem);
        asm volatile("s_waitcnt vmcnt(8)" ::: "memory");
    }
    __syncthreads();
    f32x4 S[4];
#pragma unroll
    for (int t = 0; t < 4; ++t) S[t] = (f32x4){0.f, 0.f, 0.f, 0.f};
    const int sw = (r >> 1) & 7;
    int xo[2][2], yo[4];
#pragma unroll
    for (int ks = 0; ks < 2; ++ks)
#pragma unroll
        for (int hi = 0; hi < 2; ++hi) xo[ks][hi] = r * 128 + (q & 1) * 8 + (((4 * ks + 2 * hi + (q >> 1)) ^ sw) << 4);
#pragma unroll
    for (int t = 0; t < 4; ++t) yo[t] = r * 128 + (q & 1) * 8 + (((2 * t + (q >> 1)) ^ sw) << 4);
    const int go = (16 * vg + r) * 64 + (q & 1) * 4;
#pragma unroll 1
    for (int pc = 0; pc < 128; pc += S2_G) {
        if (loader) {
            if (pc + S2_D < 128) {
#pragma unroll
                for (int c = 0; c < S2_G; ++c) s2_issue(sc, dh, vg, pc + S2_D + c, w, lane, smem);
                asm volatile("s_waitcnt vmcnt(8)" ::: "memory");
            }
            else asm volatile("s_waitcnt vmcnt(0)" ::: "memory");
        } else if (w == 0) {
            u32x2 fa[S2_G][4][2][2], fv[S2_G][4];
#pragma unroll
            for (int c2 = 0; c2 < S2_G; ++c2) {
                const unsigned char* sl = smem + ((pc + c2) % S2_NS) * S2_SLOT;
#pragma unroll
                for (int t = 0; t < 4; ++t) {
#pragma unroll
                    for (int ks = 0; ks < 2; ++ks)
#pragma unroll
                        for (int hi = 0; hi < 2; ++hi) fa[c2][t][ks][hi] = *(const u32x2*)(sl + t * 2048 + xo[ks][hi]);
                    fv[c2][t] = *(const u32x2*)(sl + 8192 + yo[t]);
                }
            }
#pragma unroll
            for (int c2 = 0; c2 < S2_G; ++c2) {
                bf16_t* S0g = (bf16_t*)(sc + SC_VK) + ((size_t)(dh * 128 + pc + c2)) * 4096;
                u32x2 sb[4];
#pragma unroll
                for (int t = 0; t < 4; ++t) { sb[t].x = pk2(S[t][0], S[t][1]); sb[t].y = pk2(S[t][2], S[t][3]); }
#pragma unroll
                for (int t = 0; t < 4; ++t) {
                    f32x4 a = (f32x4){bflo(fv[c2][t].x), bfhi(fv[c2][t].x), bflo(fv[c2][t].y), bfhi(fv[c2][t].y)};
#pragma unroll
                    for (int ks = 0; ks < 2; ++ks) a = MFMA16(mk8(fa[c2][t][ks][0], fa[c2][t][ks][1]), mk8(sb[2 * ks], sb[2 * ks + 1]), a);
                    S[t] = a;
                }
#pragma unroll
                for (int t = 0; t < 4; ++t) *(u32x2*)(S0g + go + (((2 * t + (q >> 1)) ^ sw) << 3)) = sb[t];
            }
        }
        asm volatile("" ::: "memory"); __builtin_amdgcn_s_barrier(); asm volatile("" ::: "memory");
    }
    asm volatile("s_waitcnt vmcnt(0) lgkmcnt(0)" ::: "memory");
    __syncthreads();
}

struct RAW3 { unsigned u[6][10]; float mu[6]; float kkc; };
DI unsigned raw16(const bf16_t* base, unsigned byteoff) { return *(const bf16_t*)((const unsigned char*)base + byteoff); }
DI void raw3_issue(const Params& P, int l, int item, RAW3& R) {
    const int h = (item >> 3) & 7, tci = (item & 7) + 8 * ((item >> 6) & 3) + 32 * (item >> 8), tc = tci & 127, b = tci >> 7;
    const int c = otid() & 63, g = __builtin_amdgcn_readfirstlane(otid() >> 6), t0 = tc * 64 + 8 * g, ch = h * 64 + c;
    const bf16_t* ua = (const bf16_t*)(P.ws() + WS_UA) + (size_t)b * T_ * UA_LD;
    const float* mu = P.in(I_MU) + l * 2304;
    const int tlo = t0 > 0 ? t0 - 1 : 0, thi = t0 + 8 < T_ ? t0 + 8 : T_ - 1;
    const int cols[6] = {ch, 512 + ch, 1024 + ch, 1536 + ch, 2048 + c, 2048 + 128 + c};
#pragma unroll
    for (int gi = 0; gi < 6; ++gi) {
        const unsigned col = (unsigned)cols[gi], o0 = ((unsigned)t0 * UA_LD + col) * 2u;
        R.u[gi][0] = raw16(ua, ((unsigned)tlo * UA_LD + col) * 2u); R.u[gi][9] = raw16(ua, ((unsigned)thi * UA_LD + col) * 2u);
#pragma unroll
        for (int e = 0; e < 8; ++e) R.u[gi][e + 1] = raw16(ua, o0 + (unsigned)e * (UA_LD * 2u));
        R.mu[gi] = mu[col];
    }
    R.kkc = P.in(I_KK)[l * 512 + ch];
}
DI void raw3_shift(const RAW3& R, int gi, int t0, float (&out)[8]) {
    float u[10];
#pragma unroll
    for (int e = 0; e < 10; ++e) u[e] = __uint_as_float(R.u[gi][e] << 16);
    u[0] = t0 > 0 ? u[0] : 0.f; u[9] = t0 + 8 < T_ ? u[9] : 0.f;
#pragma unroll
    for (int e = 0; e < 8; ++e) out[e] = u[e + 1] + R.mu[gi] * (0.5f * (u[e] + u[e + 2]) - u[e + 1]);
}
DI void raw3_consume(const Params& P, const RAW3& R, int l, int b, int h, int tc, FE& f, FED& fd0) {
    const int g = __builtin_amdgcn_readfirstlane(otid() >> 6), t0 = tc * 64 + 8 * g;
    raw3_shift(R, 0, t0, f.r); raw3_shift(R, 1, t0, f.k); raw3_shift(R, 2, t0, f.v); raw3_shift(R, 3, t0, f.z);
    {
        float td[8], ti[8];
        raw3_shift(R, 4, t0, td); raw3_shift(R, 5, t0, ti);
#pragma unroll
        for (int e = 0; e < 4; ++e) { fd0.dd[e] = pk2(2.f * sigm(2.f * td[2 * e]) - 1.f, 2.f * sigm(2.f * td[2 * e + 1]) - 1.f); fd0.id[e] = pk2(ti[2 * e], ti[2 * e + 1]); }
    }
    if (l > 0) {
        const int c = otid() & 63, ch = h * 64 + c;
        const bf16_t* ua = (const bf16_t*)(P.ws() + WS_UA) + (size_t)b * T_ * UA_LD; const bf16_t* VF = (const bf16_t*)(P.ws() + WS_VF);
        const float v0 = P.in(I_V0)[(l - 1) * 512 + ch];
#pragma unroll
        for (int e = 0; e < 8; ++e) {
            const unsigned tok = (unsigned)(t0 + e); const float mix = sigm(v0 + ldbf(ua, (tok * UA_LD + 2304u + (unsigned)ch) * 2u));
            const float vf = ldbf(VF, (((unsigned)b * T_ + tok) * 512u + (unsigned)ch) * 2u); f.v[e] += (vf - f.v[e]) * mix;
        }
    }
#pragma unroll
    for (int e = 0; e < 8; ++e) f.kk[e] = f.k[e] * R.kkc;
    {
        float ss[8];
#pragma unroll
        for (int e = 0; e < 8; ++e) ss[e] = f.kk[e] * f.kk[e];
        wave_sum8(ss);
#pragma unroll
        for (int e = 0; e < 8; ++e) f.kk[e] *= rsqrtf(fmaxf(ss[e], 1e-24f));
    }
}

DI void s3_phase(const Params& P, int l, unsigned char* smem) {
    const int tid = otid(), lane = tid & 63, w = __builtin_amdgcn_readfirstlane(tid >> 6), r = lane & 15, q = lane >> 4;
    bf16_t* Rs = (bf16_t*)(smem + OFF_R); bf16_t* Bs = (bf16_t*)(smem + OFF_B); bf16_t* Ks = (bf16_t*)(smem + OFF_K); bf16_t* VTs = (bf16_t*)(smem + OFF_VT);
    bf16_t* MRB = (bf16_t*)(smem + OFF_WR); bf16_t* MRK = (bf16_t*)(smem + OFF_AR); float* YS = (float*)(smem + OFF_YS);
    RAW3 R;
    { const int first = obid(); if (first < 2048) raw3_issue(P, l, first, R); }
    for (int item = obid(); item < 2048; item += gridDim.x) {
        const int h = (item >> 3) & 7, tci = (item & 7) + 8 * ((item >> 6) & 3) + 32 * (item >> 8), tc = tci & 127, b = tci >> 7;
        FE f; FED fd0, fd1; float ksum[8];
#pragma unroll
        for (int e = 0; e < 8; ++e) ksum[e] = 0.f;
        fe_dir_load(P, l, b, tc, 1, fd1);
        const float lnw = P.in(I_LNW)[l * 512 + h * 64 + lane], lnb = P.in(I_LNB)[l * 512 + h * 64 + lane], rk = P.in(I_RK)[l * 512 + h * 64 + lane];
        raw3_consume(P, R, l, b, h, tc, f, fd0);
#pragma unroll
        for (int d = 0; d < 2; ++d) {
            FED fd;
#pragma unroll
            for (int e = 0; e < 4; ++e) { fd.dd[e] = fd0.dd[e]; fd.id[e] = fd0.id[e]; }
            u32x4 btw;
            fe_dir(P, l, b, h, tc, d, f, fd, ksum, smem, false, btw);
            if (d == 1 && item + (int)gridDim.x < 2048) raw3_issue(P, l, item + (int)gridDim.x, R);
            const int which = w >> 2, mtw = w & 3, mt2 = w >> 1, nt2 = (w & 1) * 2;
            const int dh = d * 8 + h, pc = d ? 127 - tc : tc; const size_t base = ((size_t)(dh * 128 + pc)) * 4096;
            const bf16_t* U0T = (const bf16_t*)(P.scb(b) + SC_U0) + base; const bf16_t* S0 = (const bf16_t*)(P.scb(b) + SC_VK) + base; const bf16_t* AH = (const bf16_t*)(P.scb(b) + SC_AH) + base;
            const Frag2 gah = ldf_gs(AH, mt2, r, q), gs0 = ldf_gs(S0, nt2, r, q), gs1 = ldf_gs(S0, nt2 + 1, r, q);
            u32x2 gu0[2];
#pragma unroll
            for (int e = 0; e < 2; ++e) { const int vrow = (nt2 + e) * 16 + r; gu0[e] = *(const u32x2*)(U0T + vrow * 64 + (((2 * mt2 + (q >> 1)) ^ ((vrow >> 1) & 7)) << 3) + (q & 1) * 4); }
            f32x4 macc[4];
            { const Frag2 a = ldf(Rs, LP, mtw, r, q); Frag2 bb[4];
#pragma unroll
              for (int e = 0; e < 4; ++e) bb[e] = ldf(which ? Ks : Bs, LP, e, r, q);
              SCHED_FENCE();
#pragma unroll
              for (int e = 0; e < 4; ++e) macc[e] = mmf(a, bb[e], Z4); }
#pragma unroll
            for (int e = 0; e < 4; ++e) {
                const int mt = mtw, nt = e; const f32x4 acc = macc[e];
                bf16_t* O = which ? MRK : MRB;
#pragma unroll
                for (int j = 0; j < 4; ++j) { const int m = mt * 16 + 4 * q + j, n = nt * 16 + r; O[m * LP + n] = f2bf((n <= m) ? acc[j] : 0.f); }
            }
            bf16_t* UTs = (bf16_t*)(smem + OFF_AT);
#pragma unroll
            for (int e = 0; e < 2; ++e) {
                const f32x4 u = mmf(gah, e ? gs1 : gs0, (f32x4){bflo(gu0[e].x), bfhi(gu0[e].x), bflo(gu0[e].y), bfhi(gu0[e].y)});
                u32x2 t2; t2.x = pk2(u[0], u[1]); t2.y = pk2(u[2], u[3]); *(u32x2*)(UTs + ((nt2 + e) * 16 + r) * LP + mt2 * 16 + 4 * q) = t2;
            }
            LBAR();
            f32x4 y2[2];
            { const Frag2 a1 = ldf(MRK, LP, mt2, r, q), a2 = ldf(MRB, LP, mt2, r, q), a3 = ldf(Rs, LP, mt2, r, q);
              Frag2 b1[2], b2[2];
#pragma unroll
              for (int e = 0; e < 2; ++e) { b1[e] = ldf(VTs, LP, nt2 + e, r, q); b2[e] = ldf(UTs, LP, nt2 + e, r, q); }
              SCHED_FENCE();
#pragma unroll
              for (int e = 0; e < 2; ++e) { f32x4 y = mmf(a1, b1[e], Z4); y = mmf(a2, b2[e], y); y2[e] = mmf(a3, e ? gs1 : gs0, y); } }
#pragma unroll
            for (int e = 0; e < 2; ++e) {
                const int mt = mt2, nt = nt2 + e; const f32x4 y = y2[e];
#pragma unroll
                for (int j = 0; j < 4; ++j) { const int p = mt * 16 + 4 * q + j, v = nt * 16 + r;
                    if (d == 0) YS[p * 65 + v] = y[j]; else YS[(63 - p) * 65 + v] += y[j]; }
            }
            LBAR();
#pragma unroll
            for (int e = 0; e < 4; ++e) { fd0.dd[e] = fd1.dd[e]; fd0.id[e] = fd1.id[e]; }
        }
        {
            const int c = lane, g = w, ch = h * 64 + c;
            bf16_t* OA = (bf16_t*)(P.ws() + WS_OA); bf16_t* VF = (bf16_t*)(P.ws() + WS_VF);
            float y8[8], s1[8], s2[8], s3[8];
#pragma unroll
            for (int e = 0; e < 8; ++e) { const float y = YS[(8 * g + e) * 65 + c]; y8[e] = y; s1[e] = y; s2[e] = y * y; s3[e] = f.r[e] * ksum[e] * rk; }
            wave_sum8(s1); wave_sum8(s2); wave_sum8(s3);
#pragma unroll
            for (int e = 0; e < 8; ++e) {
                const int i = 8 * g + e; const size_t row = (size_t)b * T_ + tc * 64 + i;
                const float mean = s1[e] * (1.f / 64.f), var = fmaxf(s2[e] * (1.f / 64.f) - mean * mean, 0.f);
                const float yn = (y8[e] - mean) * rsqrtf(var + 64e-5f) * lnw + lnb;
                const float bon = s3[e] * f.v[e];
                const float z = f.z[e];
                const unsigned ob = ((unsigned)row * 512u + (unsigned)ch) * 2u;
                *(bf16_t*)((unsigned char*)OA + ob) = f2bf((yn + bon) * (z * sigm(z)));
                if (l == 0) *(bf16_t*)((unsigned char*)VF + ob) = f2bf(f.v[e]);
            }
        }
        LBAR();
    }
}

#define RLX_AGENT __ATOMIC_RELAXED, __HIP_MEMORY_SCOPE_AGENT
#define XB_TMO      128
#define XB_XCNT(j)  (256  + 64 * (j))
#define XB_XSUB(j)  (1280 + 64 * (j))
#define XB_XGEN(j)  (2304 + 64 * (j))
#define XB_TOP      3328
#define XB_TOPGEN   3392
#define XCD_BAR_WORDS 3456
#define XB_SPIN_CAP (1u << 18)

__device__ __forceinline__ unsigned xb_ld(unsigned* p)              { return __hip_atomic_load(p, __ATOMIC_RELAXED, __HIP_MEMORY_SCOPE_AGENT); }
__device__ __forceinline__ unsigned xb_add(unsigned* p, unsigned v) { return __hip_atomic_fetch_add(p, v, __ATOMIC_RELAXED, __HIP_MEMORY_SCOPE_AGENT); }
__device__ __forceinline__ unsigned xb_xcc_id() { return (unsigned)__builtin_amdgcn_s_getreg((3 << 11) | 20) & 0xFu; }
#define XB_SPIN(cond, bar) do { unsigned _sp = 0; while (cond) { __builtin_amdgcn_s_sleep(1); \
    if ((++_sp & 255u) == 0u) { if (xb_ld(&(bar)[XB_TMO])) break; if (_sp > XB_SPIN_CAP) { atomicAdd(&(bar)[XB_TMO], 1u); break; } } } } while (0)

struct XcdBarrier {
    unsigned* bar; unsigned x;
    volatile __attribute__((address_space(3))) unsigned* st;
};

__device__ __forceinline__ XcdBarrier xcd_barrier_post(unsigned* bar, volatile __attribute__((address_space(3))) unsigned* st) {
    XcdBarrier b; b.bar = bar; b.x = xb_xcc_id(); b.st = st;
    if (threadIdx.x == 0) (void)xb_add(&bar[XB_XCNT(b.x)], 1u);
    return b;
}
__device__ __forceinline__ void xcd_barrier_complete(unsigned* bar, unsigned x, unsigned& nloc, unsigned& nx) {
    const unsigned G = gridDim.x * gridDim.y * gridDim.z;
    unsigned sum, cnt, mine, sp = 0u;
    for (;;) {
        sum = 0u; cnt = 0u; mine = 0u;
#pragma unroll
        for (unsigned j = 0; j < 16; ++j) { const unsigned c = xb_ld(&bar[XB_XCNT(j)]); sum += c; cnt += (c > 0u) ? 1u : 0u; mine = (j == x) ? c : mine; }
        if (sum == G) break;
        __builtin_amdgcn_s_sleep(1);
        if ((++sp & 255u) == 0u) { if (xb_ld(&bar[XB_TMO])) break; if (sp > XB_SPIN_CAP) { atomicAdd(&bar[XB_TMO], 1u); break; } }
    }
    nloc = mine > 0u ? mine : 1u; nx = cnt > 0u ? cnt : 1u;
}

__device__ __forceinline__ void xcd_barrier(const XcdBarrier& b) {
    asm volatile("s_waitcnt vmcnt(0)" ::: "memory");
    __syncthreads();
    if (threadIdx.x == 0) {
        unsigned* bar = b.bar;
        __builtin_amdgcn_s_waitcnt(0);
        unsigned nloc = b.st[0], nx = b.st[1];
        if (nloc == 0u) { xcd_barrier_complete(bar, b.x, nloc, nx); b.st[0] = nloc; b.st[1] = nx; }
        const unsigned old = xb_add(&bar[XB_XSUB(b.x)], 1u);
        const unsigned gen = old / nloc;
        if (old + 1u == (gen + 1u) * nloc) {
            __builtin_amdgcn_fence(__ATOMIC_RELEASE, "agent");
            asm volatile("s_waitcnt vmcnt(0)" ::: "memory");
            const unsigned og = xb_add(&bar[XB_TOP], 1u);
            const unsigned tg = og / nx;
            if (og + 1u == (tg + 1u) * nx) xb_add(&bar[XB_TOPGEN], 1u);
            else XB_SPIN(xb_ld(&bar[XB_TOPGEN]) == tg, bar);
            __builtin_amdgcn_fence(__ATOMIC_ACQUIRE, "agent");
            xb_add(&bar[XB_XGEN(b.x)], 1u);
            asm volatile("s_waitcnt vmcnt(0)" ::: "memory");
        } else {
            XB_SPIN(xb_ld(&bar[XB_XGEN(b.x)]) == gen, bar);
            __builtin_amdgcn_fence(__ATOMIC_ACQUIRE, "agent");
            asm volatile("s_waitcnt vmcnt(0)" ::: "memory");
        }
    }
    __syncthreads();
}

DI void gbar(unsigned* ctr, unsigned target) {
    asm volatile("s_waitcnt vmcnt(0)" ::: "memory");
    __syncthreads();
    if (threadIdx.x == 0) {
        __builtin_amdgcn_fence(__ATOMIC_RELEASE, "agent");
        asm volatile("s_waitcnt vmcnt(0)" ::: "memory");
        __hip_atomic_fetch_add(ctr, 1u, __ATOMIC_RELAXED, __HIP_MEMORY_SCOPE_AGENT);
        while (__hip_atomic_load(ctr, __ATOMIC_RELAXED, __HIP_MEMORY_SCOPE_AGENT) < target) __builtin_amdgcn_s_sleep(1);
        __builtin_amdgcn_fence(__ATOMIC_ACQUIRE, "agent");
        asm volatile("s_waitcnt vmcnt(0)" ::: "memory");
    }
    __syncthreads();
}
__global__ void __launch_bounds__(512, 2) fwd_megakernel(KArgs KA) {
    extern __shared__ __attribute__((aligned(16))) unsigned char smem[];
    if (threadIdx.x == 0) {
        unsigned long long* pt = (unsigned long long*)(smem + PARAMS_OFF);
#pragma unroll
        for (int i = 0; i < 26; ++i) pt[i] = (unsigned long long)KA.in[i];
        pt[26] = (unsigned long long)KA.out; pt[27] = (unsigned long long)KA.ws;
    }
    __syncthreads();
    Params P{smem};
    XcdBarrier xbar;
    {
        volatile __attribute__((address_space(3))) unsigned* st = (volatile __attribute__((address_space(3))) unsigned*)((__attribute__((address_space(3))) unsigned char*)smem + PARAMS_OFF + 232);
        if (threadIdx.x == 0) { st[0] = 0u; st[1] = 0u; }
        __syncthreads();
        xbar = xcd_barrier_post((unsigned*)(KA.ws + WS_BAR), st);
    }
    unsigned bar_target = 0;
#define GSYNC() xcd_barrier(xbar)
#define WSP() unsigned char* ws = P.ws(); float* ssq = (float*)(ws + WS_SSQ); bf16_t* XB = (bf16_t*)(ws + WS_XB); (void)ssq; (void)XB
#ifndef PHMASK
#define PHMASK 0xffff
#endif
#define PH(k) if (PHMASK & (1 << (k)))
    static_assert(NLAYER == 2, "the layer program below is written out twice");
    { constexpr int l = 0;

        PH(0) p0_phase(P, l, smem, (l == 0) ? P.in(I_X) : P.out());
        GSYNC();
        PH(1) { WSP(); Epi<EP_U> E{ssq, (bf16_t*)(ws + WS_UA), (bf16_t*)(ws + WS_UB), nullptr, nullptr, nullptr, nullptr};
          run_gemm<EP_U>(smem, XB, (const bf16_t*)(ws + WS_WIN), l == 0 ? 3584 : 4096, 1024, E); }
        GSYNC();
        PH(2) attn_phase(P, l, smem);
        GSYNC();
        PH(3) s1_phase(P, l, smem);
        GSYNC();
        PH(4) s2_phase(P, smem);
        GSYNC();
        PH(5) s3_phase(P, l, smem);
        GSYNC();
        PH(6) { WSP(); Epi<EP_GATE> E{ssq, (bf16_t*)(ws + WS_GATES), nullptr, nullptr, nullptr, nullptr, nullptr};
          run_gemm<EP_GATE>(smem, XB, (const bf16_t*)(ws + WS_WIN) + (size_t)4096 * 1024, 2048, 1024, E); }
        PH(0) p16_phase(P, l);
        GSYNC();
        PH(7) { WSP(); static_assert(WS_OA == WS_OB + (size_t)M_ * 512 * 2 && WS_WPB == WS_WPA + (size_t)1024 * 512 * 2, "stacked operands");
          Epi<EP_PAB> E{nullptr, (bf16_t*)(ws + WS_MERGED), nullptr, (const bf16_t*)(ws + WS_GATES), nullptr, nullptr, nullptr};
          run_gemm_pair(smem, (const bf16_t*)(ws + WS_OB), (const bf16_t*)(ws + WS_WPA), E); }
        GSYNC();
        PH(9) { WSP(); Epi<EP_PLE> E{nullptr, (bf16_t*)(ws + WS_PLE), nullptr, nullptr, nullptr, nullptr, nullptr};
          run_gemm<EP_PLE>(smem, (const bf16_t*)(ws + WS_P16), (const bf16_t*)(ws + WS_WPLE), 1024, 256, E); }
        PH(10) { WSP(); Epi<EP_OUT> E{nullptr, XB, nullptr, nullptr, (l == 0) ? P.in(I_X) : nullptr, P.out(), ssq};
          run_gemm<EP_OUT>(smem, (const bf16_t*)(ws + WS_MERGED), (const bf16_t*)(ws + WS_WOUT), 1024, 1024, E); }
        GSYNC();
        PH(11) { WSP(); Epi<EP_FIN> E{ssq, XB, nullptr, (const bf16_t*)(ws + WS_PLE), nullptr, P.out(), nullptr};
          run_gemm<EP_FIN>(smem, XB, (const bf16_t*)(ws + WS_WGATE), 1024, 1024, E); }
        if (l + 1 < NLAYER) GSYNC();
    }
    { constexpr int l = 1;

        PH(0) p0_phase(P, l, smem, (l == 0) ? P.in(I_X) : P.out());
        GSYNC();
        PH(1) { WSP(); Epi<EP_U> E{ssq, (bf16_t*)(ws + WS_UA), (bf16_t*)(ws + WS_UB), nullptr, nullptr, nullptr, nullptr};
          run_gemm<EP_U>(smem, XB, (const bf16_t*)(ws + WS_WIN), l == 0 ? 3584 : 4096, 1024, E); }
        GSYNC();
        PH(2) attn_phase(P, l, smem);
        GSYNC();
        PH(3) s1_phase(P, l, smem);
        GSYNC();
        PH(4) s2_phase(P, smem);
        GSYNC();
        PH(5) s3_phase(P, l, smem);
        GSYNC();
        PH(6) { WSP(); Epi<EP_GATE> E{ssq, (bf16_t*)(ws + WS_GATES), nullptr, nullptr, nullptr, nullptr, nullptr};
          run_gemm<EP_GATE>(smem, XB, (const bf16_t*)(ws + WS_WIN) + (size_t)4096 * 1024, 2048, 1024, E); }
        PH(0) p16_phase(P, l);
        GSYNC();
        PH(7) { WSP(); static_assert(WS_OA == WS_OB + (size_t)M_ * 512 * 2 && WS_WPB == WS_WPA + (size_t)1024 * 512 * 2, "stacked operands");
          Epi<EP_PAB> E{nullptr, (bf16_t*)(ws + WS_MERGED), nullptr, (const bf16_t*)(ws + WS_GATES), nullptr, nullptr, nullptr};
          run_gemm_pair(smem, (const bf16_t*)(ws + WS_OB), (const bf16_t*)(ws + WS_WPA), E); }
        GSYNC();
        PH(9) { WSP(); Epi<EP_PLE> E{nullptr, (bf16_t*)(ws + WS_PLE), nullptr, nullptr, nullptr, nullptr, nullptr};
          run_gemm<EP_PLE>(smem, (const bf16_t*)(ws + WS_P16), (const bf16_t*)(ws + WS_WPLE), 1024, 256, E); }
        PH(10) { WSP(); Epi<EP_OUT> E{nullptr, XB, nullptr, nullptr, (l == 0) ? P.in(I_X) : nullptr, P.out(), ssq};
          run_gemm<EP_OUT>(smem, (const bf16_t*)(ws + WS_MERGED), (const bf16_t*)(ws + WS_WOUT), 1024, 1024, E); }
        GSYNC();
        PH(11) { WSP(); Epi<EP_FIN> E{ssq, XB, nullptr, (const bf16_t*)(ws + WS_PLE), nullptr, P.out(), nullptr};
          run_gemm<EP_FIN>(smem, XB, (const bf16_t*)(ws + WS_WGATE), 1024, 1024, E); }
        if (l + 1 < NLAYER) GSYNC();
    }
}

extern "C" void kernel_launch(void* const* d_in, const int* in_sizes, int n_in, void* d_out, int out_size, void* d_ws, size_t ws_size, hipStream_t stream) {
    static int grid = 0;
    if (grid == 0) {
        if (n_in != 26 || ws_size < WS_END) { fprintf(stderr, "kernel_launch: unexpected n_in %d / ws_size %zu\n", n_in, ws_size); grid = -1; return; }
        int dev = 0, cus = 0, per_cu = 0;
        hipGetDevice(&dev); hipDeviceGetAttribute(&cus, hipDeviceAttributeMultiprocessorCount, dev);
        hipFuncSetAttribute((const void*)fwd_megakernel, hipFuncAttributeMaxDynamicSharedMemorySize, LDS_BYTES);
        hipOccupancyMaxActiveBlocksPerMultiprocessor(&per_cu, (const void*)fwd_megakernel, 512, LDS_BYTES);
        if (per_cu < 1) { fprintf(stderr, "kernel_launch: occupancy query says %d\n", per_cu); per_cu = 1; }
        if (per_cu > 1) per_cu = 1;
        grid = cus * per_cu;
    }
    if (grid < 0) return;
    KArgs p{};
    for (int i = 0; i < 26; ++i) p.in[i] = (const float*)d_in[i];
    p.out = (float*)d_out; p.ws = (unsigned char*)d_ws;
    hipMemsetAsync((unsigned char*)d_ws + WS_BAR, 0, XCD_BAR_WORDS * 4, stream);
    void* args[] = {&p};
    hipError_t e = hipLaunchCooperativeKernel((void*)fwd_megakernel, dim3(grid), dim3(512), args, LDS_BYTES, stream);
    if (e != hipSuccess) fprintf(stderr, "cooperative launch failed: %s (grid %d)\n", hipGetErrorString(e), grid);
}
```

```cpp
#include <hip/hip_runtime.h>
#include <hip/hip_cooperative_groups.h>
#include <cstdio>
#include <cstdint>
namespace cg = cooperative_groups;

#define DI __device__ __forceinline__
typedef unsigned short bf16_t;
typedef short bf16x8 __attribute__((ext_vector_type(8)));
typedef short bf16x4 __attribute__((ext_vector_type(4)));
typedef float f32x4 __attribute__((ext_vector_type(4)));
typedef unsigned u32x4 __attribute__((ext_vector_type(4)));
typedef unsigned u32x2 __attribute__((ext_vector_type(2)));


DI int otid() { int t = threadIdx.x; asm volatile("" : "+v"(t)); return t; }
DI int obid() { int b = blockIdx.x; asm volatile("" : "+s"(b)); return b; }
namespace pg8 {
#define PG8_LAS __attribute__((address_space(3)))
constexpr int BM = 256, BK = 64, HALF = 128, HTB = HALF * BK * 2, STAGE_BYTES = 8 * HTB, NXCD = 8, WGM = 8;
__host__ __device__ __forceinline__ int lds_byte(int r, int c) { const int st = (r >> 4) * 2 + (c >> 5), rr = r & 15, cc = c & 31, ob = rr * 64 + cc * 2; return st * 1024 + (ob ^ (((ob >> 9) & 1) << 5)); }
__host__ __device__ __forceinline__ void stage_rc(int b, int& R, int& C) { const int st = b / 1024, sb = b % 1024, swz = sb ^ (((sb >> 9) & 1) << 5); R = (st >> 1) * 16 + swz / 64; C = (st & 1) * 32 + (swz % 64) / 2; }
__host__ __device__ __forceinline__ int perm32(int rho) { const int n = rho >> 4, i = rho & 15; return 8 * (i >> 2) + 4 * n + (i & 3); }
struct Unit { int pm, pn; };
struct Gemm { const bf16_t* A; const bf16_t* Bt; int M, N, K; };
struct StaticOrder {
    int nM, nN, nwg, G, c;
    __host__ __device__ void init(int M, int N, int G_, int c_) { nM = M / BM; nN = N / BM; nwg = nM * nN; G = G_; c = c_; }
    __host__ __device__ bool next(int i, Unit& u) const {
        const long L = (long)i * G + c; if (L >= nwg) return false;
        int wgid = (int)L; { const int q = nwg / NXCD, r = nwg % NXCD, xcd = wgid % NXCD, off = wgid / NXCD; wgid = (xcd < r ? xcd * (q + 1) : r * (q + 1) + (xcd - r) * q) + off; }
        const int nig = WGM * nN, gid = wgid / nig, fm = gid * WGM, gsz = (nM - fm) < WGM ? (nM - fm) : WGM;
        u.pm = fm + ((wgid % nig) % gsz); u.pn = (wgid % nig) / gsz; return true;
    }
    __device__ __forceinline__ void a_ready(const Unit&) const {}
    __device__ __forceinline__ void done(const Unit&) const {}
};
__device__ __forceinline__ unsigned cvt_pk_bf16(float lo, float hi) { unsigned r; asm volatile("v_cvt_pk_bf16_f32 %0, %1, %2" : "=v"(r) : "v"(lo), "v"(hi)); return r; }
template <class Epi, class Sched, bool ALIGN_EPI = false, bool SP2 = false>
__device__ __forceinline__ void gemm_phase(PG8_LAS unsigned char* lds, const Gemm g, const Sched& S, const Epi& E) {
    const int tid = otid(), wid = __builtin_amdgcn_readfirstlane(tid >> 6), lane = tid & 63, wr = wid >> 2, wc = wid & 3, fr = lane & 15, fq = lane >> 4;
    const int K = g.K, nt = K / BK;
    unsigned voffA[2], voffB[2];
#pragma unroll
    for (int i = 0; i < 2; ++i) { int R, C; stage_rc(tid * 16 + i * 8192, R, C); const int Rb = Epi::PERM ? ((R & ~31) + perm32(R & 31)) : R;
        voffA[i] = (unsigned)(R * K + C) * 2u; voffB[i] = (unsigned)(Rb * K + C) * 2u; }
    const size_t kstep = (size_t)(BK * 2);
    const size_t hstep = (size_t)HALF * K * 2;
    const size_t tstep = 2 * hstep;
    const unsigned ldsw = (unsigned)wid * 1024u;
    const int aoff = lds_byte(wr * 64 + fr, fq * 8), boff = lds_byte(wc * 32 + fr, fq * 8);
#define PG8_SA(b, h) (((b) * 2 + (h)) * HTB)
#define PG8_SB(b, h) ((4 + (b) * 2 + (h)) * HTB)
#define PG8_STAGE(bufoff, gbase, voff) do { _Pragma("unroll") for (int _i = 0; _i < 2; ++_i) \
        __builtin_amdgcn_global_load_lds((const unsigned*)((const char*)(gbase) + (voff)[_i]), (PG8_LAS unsigned*)(lds + (bufoff) + ldsw + _i * 8192), 16, 0, 0); } while (0)
#define PG8_LDA(dst, b, h) do { _Pragma("unroll") for (int m = 0; m < 4; ++m) _Pragma("unroll") for (int k = 0; k < 2; ++k) dst[m][k] = *(const PG8_LAS bf16x8*)(lds + PG8_SA(b, h) + aoff + m * 2048 + k * 1024); } while (0)
#define PG8_LDB(dst, b, h) do { _Pragma("unroll") for (int n = 0; n < 2; ++n) _Pragma("unroll") for (int k = 0; k < 2; ++k) dst[n][k] = *(const PG8_LAS bf16x8*)(lds + PG8_SB(b, h) + boff + n * 2048 + k * 1024); } while (0)
#define PG8_MMA(ai, bj, At, Bt) do { __builtin_amdgcn_s_setprio(1); _Pragma("unroll") for (int m = 0; m < 4; ++m) _Pragma("unroll") for (int n = 0; n < 2; ++n) _Pragma("unroll") for (int k = 0; k < 2; ++k) \
        acc[ai][bj][m][n] = __builtin_amdgcn_mfma_f32_16x16x32_bf16(Bt[n][k], At[m][k], acc[ai][bj][m][n], 0, 0, 0); __builtin_amdgcn_s_setprio(0); } while (0)
#define PG8_WAIT_V(n) asm volatile("s_waitcnt vmcnt(" #n ")" ::: "memory")
#define PG8_WAIT_L(n) asm volatile("s_waitcnt lgkmcnt(" #n ")" ::: "memory")
#define PG8_BAR __builtin_amdgcn_s_barrier()
#define PG8_SCHED __builtin_amdgcn_sched_barrier(0)
    Unit cur, nxt; int ui = 0;
    if (!S.next(0, cur)) return;
    f32x4 acc[2][2][4][2];
#pragma unroll
    for (int a = 0; a < 2; ++a)
#pragma unroll
        for (int b = 0; b < 2; ++b)
#pragma unroll
            for (int m = 0; m < 4; ++m)
#pragma unroll
                for (int n = 0; n < 2; ++n) acc[a][b][m][n] = (f32x4){0.f, 0.f, 0.f, 0.f};
    bf16x8 At[4][2], B0[2][2], B1[2][2];
    const char* cA = (const char*)g.A + (size_t)cur.pm * tstep; const char* cB = (const char*)g.Bt + (size_t)cur.pn * tstep;
    S.a_ready(cur);
    if constexpr (SP2) {
        PG8_STAGE(PG8_SB(0, 0), cB, voffB); PG8_STAGE(PG8_SB(0, 1), cB + hstep, voffB); PG8_STAGE(PG8_SA(0, 0), cA, voffA); PG8_STAGE(PG8_SA(0, 1), cA + hstep, voffA);
        if (wr == 1) PG8_BAR;
        PG8_WAIT_V(2); PG8_BAR;
        PG8_STAGE(PG8_SB(1, 0), cB + kstep, voffB); PG8_STAGE(PG8_SA(1, 0), cA + kstep, voffA); PG8_STAGE(PG8_SB(1, 1), cB + hstep + kstep, voffB);
        PG8_WAIT_V(6); PG8_BAR;
    } else {
        PG8_STAGE(PG8_SB(0, 0), cB, voffB); PG8_STAGE(PG8_SA(0, 0), cA, voffA); PG8_STAGE(PG8_SB(0, 1), cB + hstep, voffB); PG8_STAGE(PG8_SA(0, 1), cA + hstep, voffA);
        if (wr == 1) PG8_BAR;
        PG8_WAIT_V(4); PG8_BAR;
        PG8_STAGE(PG8_SB(1, 0), cB + kstep, voffB); PG8_STAGE(PG8_SA(1, 0), cA + kstep, voffA); PG8_STAGE(PG8_SB(1, 1), cB + hstep + kstep, voffB);
        PG8_WAIT_V(6); PG8_BAR;
    }
    for (;;) {
        const bool has_next = S.next(ui + 1, nxt);
        const char* nA = has_next ? (const char*)g.A + (size_t)nxt.pm * tstep : cA; const char* nB = has_next ? (const char*)g.Bt + (size_t)nxt.pn * tstep : cB;
        for (int t = 0; t < nt; t += 2) {
            const bool last = (t == nt - 2);
            const char* a1 = cA + (size_t)(t + 1) * kstep;
            const char* a2 = last ? nA : cA + (size_t)(t + 2) * kstep; const char* b2 = last ? nB : cB + (size_t)(t + 2) * kstep;
            const char* a3 = a2 + kstep; const char* b3 = b2 + kstep;
            if (last && has_next) S.a_ready(nxt);
            if constexpr (SP2) {
            PG8_LDB(B0, 0, 0); PG8_LDB(B1, 0, 1); PG8_SCHED; PG8_LDA(At, 0, 0); PG8_STAGE(PG8_SA(1, 1), a1 + hstep, voffA);
            PG8_WAIT_V(8); PG8_WAIT_L(0); PG8_BAR; PG8_MMA(0, 0, At, B0); PG8_MMA(0, 1, At, B1); PG8_BAR; PG8_SCHED;
            PG8_LDA(At, 0, 1); PG8_STAGE(PG8_SB(0, 0), b2, voffB); PG8_STAGE(PG8_SB(0, 1), b2 + hstep, voffB); PG8_STAGE(PG8_SA(0, 0), a2, voffA);
            PG8_WAIT_V(8); PG8_WAIT_L(0); PG8_BAR; PG8_MMA(1, 0, At, B0); PG8_MMA(1, 1, At, B1); PG8_BAR; PG8_SCHED;
            PG8_LDB(B0, 1, 0); PG8_LDB(B1, 1, 1); PG8_SCHED; PG8_LDA(At, 1, 0); PG8_STAGE(PG8_SA(0, 1), a2 + hstep, voffA);
            PG8_WAIT_V(8); PG8_WAIT_L(0); PG8_BAR; PG8_MMA(0, 0, At, B0); PG8_MMA(0, 1, At, B1); PG8_BAR; PG8_SCHED;
            PG8_LDA(At, 1, 1); PG8_STAGE(PG8_SB(1, 0), b3, voffB); PG8_STAGE(PG8_SB(1, 1), b3 + hstep, voffB); PG8_STAGE(PG8_SA(1, 0), a3, voffA);
            PG8_WAIT_V(8); PG8_WAIT_L(0); PG8_BAR; PG8_MMA(1, 0, At, B0); PG8_MMA(1, 1, At, B1); PG8_BAR; PG8_SCHED;
            } else {
            PG8_LDB(B0, 0, 0); PG8_SCHED; PG8_LDA(At, 0, 0); PG8_STAGE(PG8_SA(1, 1), a1 + hstep, voffA);
            PG8_WAIT_L(8); PG8_BAR; PG8_WAIT_L(0); PG8_MMA(0, 0, At, B0); PG8_BAR; PG8_SCHED;
            PG8_LDB(B1, 0, 1); PG8_STAGE(PG8_SB(0, 0), b2, voffB);
            PG8_BAR; PG8_WAIT_L(0); PG8_MMA(0, 1, At, B1); PG8_BAR;
            PG8_LDA(At, 0, 1); PG8_STAGE(PG8_SA(0, 0), a2, voffA);
            PG8_BAR; PG8_WAIT_L(0); PG8_MMA(1, 0, At, B0); PG8_BAR; PG8_SCHED;
            PG8_STAGE(PG8_SB(0, 1), b2 + hstep, voffB);
            PG8_WAIT_V(6); PG8_BAR; PG8_MMA(1, 1, At, B1); PG8_BAR;
            PG8_LDB(B0, 1, 0); PG8_SCHED; PG8_LDA(At, 1, 0); PG8_STAGE(PG8_SA(0, 1), a2 + hstep, voffA);
            PG8_WAIT_L(8); PG8_BAR; PG8_WAIT_L(0); PG8_MMA(0, 0, At, B0); PG8_BAR; PG8_SCHED;
            PG8_LDB(B1, 1, 1); PG8_STAGE(PG8_SB(1, 0), b3, voffB);
            PG8_BAR; PG8_WAIT_L(0); PG8_MMA(0, 1, At, B1); PG8_BAR;
            PG8_LDA(At, 1, 1); PG8_STAGE(PG8_SA(1, 0), a3, voffA);
            PG8_BAR; PG8_WAIT_L(0); PG8_MMA(1, 0, At, B0); PG8_BAR; PG8_SCHED;
            PG8_STAGE(PG8_SB(1, 1), b3 + hstep, voffB);
            PG8_WAIT_V(6); PG8_BAR; PG8_MMA(1, 1, At, B1); PG8_BAR;
            }
        }
        if constexpr (ALIGN_EPI) { if (wr == 0) PG8_BAR; }
        bool keep = false;
        if constexpr (Epi::CHAIN) keep = E.mid(acc, cur, wr, wc, fr, fq);
        if (!keep) { if constexpr (!Epi::AFTER_DRAIN) { E(acc, cur, wr, wc, fr, fq); S.done(cur); } }
        if (!has_next) break;
        if (!keep)
#pragma unroll
        for (int a = 0; a < 2; ++a)
#pragma unroll
            for (int b = 0; b < 2; ++b)
#pragma unroll
                for (int m = 0; m < 4; ++m)
#pragma unroll
                    for (int n = 0; n < 2; ++n) acc[a][b][m][n] = (f32x4){0.f, 0.f, 0.f, 0.f};
        cur = nxt; cA = nA; cB = nB; ++ui;
        if constexpr (ALIGN_EPI) { if (wr == 1) PG8_BAR; }
    }
    PG8_WAIT_V(0);
    if constexpr (!ALIGN_EPI) { if (wr == 0) PG8_BAR; }
    PG8_BAR;
    if constexpr (Epi::AFTER_DRAIN) { E.fused(acc, cur, wr, wc, fr, fq, lds, wid, lane); S.done(cur); }
#undef PG8_SA
#undef PG8_SB
#undef PG8_STAGE
#undef PG8_LDA
#undef PG8_LDB
#undef PG8_MMA
#undef PG8_WAIT_V
#undef PG8_WAIT_L
#undef PG8_BAR
#undef PG8_SCHED
}
}

constexpr int T_ = 8192, M_ = 16384, DM = 1024, NLAYER = 2;
constexpr int UA_LD = 2816, UB_LD = 1280;
constexpr size_t MiB = 1u << 20;
constexpr size_t WS_SSQ = 0, WS_DL = 1 * MiB, WS_BAR = 20 * MiB + 768 * 1024, WS_WIN = 2 * MiB, WS_WPA = 14 * MiB, WS_WPB = 15 * MiB, WS_WOUT = 16 * MiB, WS_WGATE = 18 * MiB,
                 WS_WPLE = 20 * MiB, WS_UPT = 20 * MiB + 512 * 1024, WS_XB = 21 * MiB, WS_VF = 53 * MiB, WS_OB = 69 * MiB, WS_OA = 85 * MiB, WS_UA = 101 * MiB,
                 WS_SC = 189 * MiB, WS_UB = 189 * MiB, WS_GATES = 101 * MiB, WS_P16 = 165 * MiB, WS_MERGED = 189 * MiB, WS_PLE = 221 * MiB, WS_END = 253 * MiB;
constexpr size_t SC_AH = 0, SC_BT = 16 * MiB, SC_U0 = 32 * MiB, SC_VK = 48 * MiB;
constexpr int LDS_BYTES = 147456;

struct KArgs { const float* in[26]; float* out; unsigned char* ws; };
constexpr int PARAMS_OFF = LDS_BYTES - 256;
struct Params {
    const unsigned char* sm;
    DI unsigned long long ld(int i) const { unsigned a = (unsigned)(PARAMS_OFF + i * 8); asm volatile("" : "+v"(a)); const unsigned long long v = *(const unsigned long long*)(sm + a);
        const unsigned lo = __builtin_amdgcn_readfirstlane((unsigned)v), hi = __builtin_amdgcn_readfirstlane((unsigned)(v >> 32)); return ((unsigned long long)hi << 32) | lo; }
    DI const float* in(int i) const { return (const float*)(__attribute__((address_space(1))) const float*)ld(i); }
    DI float* out() const { return (float*)(__attribute__((address_space(1))) float*)ld(26); }
    DI unsigned char* scb(int b) const { return b ? (unsigned char*)out() : ws() + WS_SC; }
    DI unsigned char* ws() const { return (unsigned char*)(__attribute__((address_space(1))) unsigned char*)ld(27); }
};
enum { I_X = 0, I_P, I_NORMG, I_WIN, I_MU, I_W0, I_DUP, I_A0, I_IUP, I_VD, I_VU, I_V0, I_KK, I_KA, I_RK, I_LNW, I_LNB, I_QG, I_KG, I_SINK, I_PA, I_PB, I_WOUT, I_PLEG, I_PLEW, I_PLEP };

typedef float f32x2_t __attribute__((ext_vector_type(2)));
typedef __bf16 bf16x2_t __attribute__((ext_vector_type(2)));
DI unsigned pk2(float lo, float hi) { const f32x2_t v = {lo, hi}; const bf16x2_t b = __builtin_convertvector(v, bf16x2_t); return __builtin_bit_cast(unsigned, b); }
DI unsigned short f2bf(float f) { return (unsigned short)(pk2(f, 0.f) & 0xffffu); }
DI float bf2f(unsigned short h) { return __uint_as_float(((unsigned)h) << 16); }
DI float bflo(unsigned w) { return __uint_as_float(w << 16); }
DI float bfhi(unsigned w) { return __uint_as_float(w & 0xffff0000u); }
DI float sigm(float x) { return __builtin_amdgcn_rcpf(1.f + __expf(-x)); }
DI void wave_sum8(float (&v)[8]) {
    const int lane = __lane_id();
    const bool h32 = lane & 32, h16 = lane & 16, h8 = lane & 8;
    float a[4], b2[2], c1;
#pragma unroll
    for (int i = 0; i < 4; ++i) { const float send = h32 ? v[i] : v[4 + i], keep = h32 ? v[4 + i] : v[i]; a[i] = keep + __shfl_xor(send, 32); }
#pragma unroll
    for (int i = 0; i < 2; ++i) { const float send = h16 ? a[i] : a[2 + i], keep = h16 ? a[2 + i] : a[i]; b2[i] = keep + __shfl_xor(send, 16); }
    { const float send = h8 ? b2[0] : b2[1], keep = h8 ? b2[1] : b2[0]; c1 = keep + __shfl_xor(send, 8); }
    c1 += __shfl_xor(c1, 4); c1 += __shfl_xor(c1, 2); c1 += __shfl_xor(c1, 1);
#pragma unroll
    for (int e = 0; e < 8; ++e) v[e] = __int_as_float(__builtin_amdgcn_readlane(__float_as_int(c1), ((e >> 2) & 1) * 32 + ((e >> 1) & 1) * 16 + (e & 1) * 8));
}
DI float wave_sum(float v) {
#pragma unroll
    for (int o = 32; o; o >>= 1) v += __shfl_xor(v, o);
    return v;
}
#define MFMA16(a, b, c) __builtin_amdgcn_mfma_f32_16x16x32_bf16((a), (b), (c), 0, 0, 0)

enum { EP_U = 0, EP_GATE, EP_PA, EP_PB, EP_PLE, EP_OUT, EP_FIN, EP_PAB };
template <int MODE> struct Epi {
    static constexpr bool PERM = true, AFTER_DRAIN = false, CHAIN = (MODE == EP_PAB);
    const float* ssq;
    bf16_t* o0; bf16_t* o1;
    const bf16_t* g;
    const float* xres; float* xout; float* ssq_out;
    DI bool mid(f32x4 (&acc)[2][2][4][2], const pg8::Unit& u, int wr, int wc, int fr, int fq) const {
        if (u.pn >= 4) return false;
        const int row0 = (u.pm - 64) * 256 + wr * 64 + fr, colb = u.pn * 256 + wc * 32 + 8 * fq;
#pragma unroll
        for (int ai = 0; ai < 2; ++ai)
#pragma unroll
            for (int m = 0; m < 4; ++m)
#pragma unroll
                for (int bj = 0; bj < 2; ++bj) {
                    const size_t o = (size_t)(row0 + ai * 128 + m * 16) * 2048 + colb + bj * 128;
                    const u32x4 ga = *(const u32x4*)(g + o), gb = *(const u32x4*)(g + o + 1024);
                    const float ra[8] = {bflo(ga.x), bfhi(ga.x), bflo(ga.y), bfhi(ga.y), bflo(ga.z), bfhi(ga.z), bflo(ga.w), bfhi(ga.w)};
                    const float rb[8] = {bflo(gb.x), bfhi(gb.x), bflo(gb.y), bfhi(gb.y), bflo(gb.z), bfhi(gb.z), bflo(gb.w), bfhi(gb.w)};
#pragma unroll
                    for (int e = 0; e < 4; ++e) { acc[ai][bj][m][0][e] *= ra[e] * __builtin_amdgcn_rcpf(rb[e]); acc[ai][bj][m][1][e] *= ra[4 + e] * __builtin_amdgcn_rcpf(rb[4 + e]); }
                }
        return true;
    }
    DI void operator()(const f32x4 (&acc)[2][2][4][2], const pg8::Unit& u0, int wr, int wc, int fr, int fq) const {
        pg8::Unit u = u0; if (MODE == EP_PAB) u.pn -= 4;
        const int row0 = u.pm * 256 + wr * 64 + fr, colb = u.pn * 256 + wc * 32 + 8 * fq;
#pragma unroll
        for (int ai = 0; ai < 2; ++ai)
#pragma unroll
            for (int m = 0; m < 4; ++m) {
                const int row = row0 + ai * 128 + m * 16;
                float rs = 1.f;
                if (MODE == EP_U || MODE == EP_GATE) rs = rsqrtf(ssq[(size_t)row * 16] * (1.0f / 1024.0f) + 1e-6f);
                if (MODE == EP_FIN) {
                    const f32x4* sp = (const f32x4*)(ssq + (size_t)row * 16);
                    f32x4 a = sp[0], b = sp[1], c = sp[2], d = sp[3];
                    float s = ((a[0] + a[1]) + (a[2] + a[3])) + ((b[0] + b[1]) + (b[2] + b[3])) + ((c[0] + c[1]) + (c[2] + c[3])) + ((d[0] + d[1]) + (d[2] + d[3]));
                    rs = rsqrtf(s * (1.0f / 1024.0f) + 1e-6f);
                }
                float sq = 0.f;
#pragma unroll
                for (int bj = 0; bj < 2; ++bj) {
                    const int col = colb + bj * 128;
                    float v[8];
#pragma unroll
                    for (int e = 0; e < 4; ++e) { v[e] = acc[ai][bj][m][0][e] * rs; v[4 + e] = acc[ai][bj][m][1][e] * rs; }
                    if (MODE == EP_U) {
                        bf16_t* dst;
                        if (u.pn < 9) dst = o0 + (size_t)row * UA_LD + col;
                        else if (u.pn < 14) dst = o1 + (size_t)row * UB_LD + (col - 2304);
                        else dst = o0 + (size_t)row * UA_LD + 2304 + (col - 3584);
                        u32x4 w; w.x = pk2(v[0], v[1]); w.y = pk2(v[2], v[3]); w.z = pk2(v[4], v[5]); w.w = pk2(v[6], v[7]);
                        *(u32x4*)dst = w;
                    } else if (MODE == EP_GATE) {
                        u32x4 w; w.x = pk2(sigm(v[0]), sigm(v[1])); w.y = pk2(sigm(v[2]), sigm(v[3])); w.z = pk2(sigm(v[4]), sigm(v[5])); w.w = pk2(sigm(v[6]), sigm(v[7]));
                        *(u32x4*)(o0 + (size_t)row * 2048 + col) = w;
                    } else if (MODE == EP_PA || MODE == EP_PB) {
                        const u32x4 gw = *(const u32x4*)(g + (size_t)row * 2048 + (MODE == EP_PB ? 1024 : 0) + col);
                        float gg[8] = {bflo(gw.x), bfhi(gw.x), bflo(gw.y), bfhi(gw.y), bflo(gw.z), bfhi(gw.z), bflo(gw.w), bfhi(gw.w)};
                        bf16_t* dst = o0 + (size_t)row * 1024 + col;
                        float o[8];
                        if (MODE == EP_PB) { const u32x4 ow = *(const u32x4*)dst; o[0] = bflo(ow.x); o[1] = bfhi(ow.x); o[2] = bflo(ow.y); o[3] = bfhi(ow.y); o[4] = bflo(ow.z); o[5] = bfhi(ow.z); o[6] = bflo(ow.w); o[7] = bfhi(ow.w); }
                        else { for (int e = 0; e < 8; ++e) o[e] = 0.f; }
#pragma unroll
                        for (int e = 0; e < 8; ++e) o[e] += gg[e] * v[e];
                        u32x4 w; w.x = pk2(o[0], o[1]); w.y = pk2(o[2], o[3]); w.z = pk2(o[4], o[5]); w.w = pk2(o[6], o[7]);
                        *(u32x4*)dst = w;
                    } else if (MODE == EP_PAB) {
                        const u32x4 gw = *(const u32x4*)(g + (size_t)row * 2048 + 1024 + col);
                        const float gg[8] = {bflo(gw.x), bfhi(gw.x), bflo(gw.y), bfhi(gw.y), bflo(gw.z), bfhi(gw.z), bflo(gw.w), bfhi(gw.w)};
                        u32x4 w; w.x = pk2(gg[0] * v[0], gg[1] * v[1]); w.y = pk2(gg[2] * v[2], gg[3] * v[3]); w.z = pk2(gg[4] * v[4], gg[5] * v[5]); w.w = pk2(gg[6] * v[6], gg[7] * v[7]);
                        *(u32x4*)(o0 + (size_t)row * 1024 + col) = w;
                    } else if (MODE == EP_PLE) {
                        u32x4 w; w.x = pk2(v[0], v[1]); w.y = pk2(v[2], v[3]); w.z = pk2(v[4], v[5]); w.w = pk2(v[6], v[7]);
                        *(u32x4*)(o0 + (size_t)row * 1024 + col) = w;
                    } else if (MODE == EP_OUT) {
                        float o[8];
                        if (xres) {
                            const f32x4 x0 = *(const f32x4*)(xres + (size_t)row * 1024 + col), x1 = *(const f32x4*)(xres + (size_t)row * 1024 + col + 4);
#pragma unroll
                            for (int e = 0; e < 4; ++e) { o[e] = x0[e] + v[e]; o[4 + e] = x1[e] + v[4 + e]; }
                        } else {
                            const u32x4 xw = *(const u32x4*)(o0 + (size_t)row * 1024 + col);
                            o[0] = bflo(xw.x) + v[0]; o[1] = bfhi(xw.x) + v[1]; o[2] = bflo(xw.y) + v[2]; o[3] = bfhi(xw.y) + v[3];
                            o[4] = bflo(xw.z) + v[4]; o[5] = bfhi(xw.z) + v[5]; o[6] = bflo(xw.w) + v[6]; o[7] = bfhi(xw.w) + v[7];
                        }
#pragma unroll
                        for (int e = 0; e < 8; ++e) sq += o[e] * o[e];
                        u32x4 w; w.x = pk2(o[0], o[1]); w.y = pk2(o[2], o[3]); w.z = pk2(o[4], o[5]); w.w = pk2(o[6], o[7]);
                        *(u32x4*)(o0 + (size_t)row * 1024 + col) = w;
                    } else if (MODE == EP_FIN) {
                        const u32x4 xw = *(const u32x4*)(o0 + (size_t)row * 1024 + col);
                        const f32x4 x0 = (f32x4){bflo(xw.x), bfhi(xw.x), bflo(xw.y), bfhi(xw.y)}, x1 = (f32x4){bflo(xw.z), bfhi(xw.z), bflo(xw.w), bfhi(xw.w)};
                        const u32x4 pw = *(const u32x4*)(g + (size_t)row * 1024 + col);
                        float pp[8] = {bflo(pw.x), bfhi(pw.x), bflo(pw.y), bfhi(pw.y), bflo(pw.z), bfhi(pw.z), bflo(pw.w), bfhi(pw.w)};
                        float o[8];
#pragma unroll
                        for (int e = 0; e < 4; ++e) { o[e] = x0[e] + sigm(v[e]) * pp[e]; o[4 + e] = x1[e] + sigm(v[4 + e]) * pp[4 + e]; }
                        if (ssq_out) {
#pragma unroll
                            for (int e = 0; e < 8; ++e) sq += o[e] * o[e];
                            u32x4 w; w.x = pk2(o[0], o[1]); w.y = pk2(o[2], o[3]); w.z = pk2(o[4], o[5]); w.w = pk2(o[6], o[7]);
                            *(u32x4*)(o1 + (size_t)row * 1024 + col) = w;
                        } else {
                            *(f32x4*)(xout + (size_t)row * 1024 + col) = (f32x4){o[0], o[1], o[2], o[3]};
                            *(f32x4*)(xout + (size_t)row * 1024 + col + 4) = (f32x4){o[4], o[5], o[6], o[7]};
                        }
                    }
                }
                if (MODE == EP_OUT || (MODE == EP_FIN && ssq_out)) {
                    sq += __shfl_xor(sq, 16); sq += __shfl_xor(sq, 32);
                    if (fq == 0) ssq_out[(size_t)row * 16 + u.pn * 4 + wc] = sq;
                }
            }
    }
};

struct PairOrder {
    pg8::StaticOrder so;
    DI void init(int G, int c) { so.init(M_, 1024, G, c); }
    DI bool next(int i, pg8::Unit& u) const { pg8::Unit t; if (!so.next(i >> 1, t)) return false; if (i & 1) { u.pm = t.pm; u.pn = t.pn + 4; } else { u.pm = t.pm + 64; u.pn = t.pn; } return true; }
    DI void a_ready(const pg8::Unit&) const {}
    DI void done(const pg8::Unit&) const {}
};
DI void run_gemm_pair(unsigned char* smem, const bf16_t* Astk, const bf16_t* Bstk, const Epi<EP_PAB>& E) {
    int N = 2048, K = 512;
    asm volatile("" : "+s"(N), "+s"(K));
    pg8::Gemm g{Astk, Bstk, 2 * M_, N, K}; PairOrder S; S.init((int)gridDim.x, obid());
    pg8::gemm_phase<Epi<EP_PAB>, PairOrder, true, true>((PG8_LAS unsigned char*)smem, g, S, E);
    __syncthreads();
}
template <int MODE> DI void run_gemm(unsigned char* smem, const bf16_t* A, const bf16_t* Bt, int N, int K, const Epi<MODE>& E) {
    asm volatile("" : "+s"(N), "+s"(K));
    pg8::Gemm g{A, Bt, M_, N, K}; pg8::StaticOrder S; S.init(M_, N, (int)gridDim.x, (int)obid());
    pg8::gemm_phase<Epi<MODE>, pg8::StaticOrder, true, true>((PG8_LAS unsigned char*)smem, g, S, E);
    __syncthreads();
}

DI void transpose_job(const float* src, int lds_, const float* g, bf16_t* dst, int ldd, int K, int N, float* sm, int& rot) {
    const int tid = otid(), nk = K >> 6, nn = N >> 8, nt = nk * nn, G = gridDim.x;
    int first = obid() - rot; if (first < 0) first += G;
    rot = (rot + nt) % G;
    for (int t = first; t < nt; t += G) {
        const int k0 = (t % nk) << 6, n0 = (t / nk) << 8;
        f32x4 v8[8]; float g8[8];
#pragma unroll
        for (int i = 0; i < 8; ++i) {
            const int idx = tid + 512 * i, k = idx >> 6, n4 = (idx & 63) * 4;
            v8[i] = *(const f32x4*)(src + (size_t)(k0 + k) * lds_ + n0 + n4);
            g8[i] = g ? g[k0 + k] : 1.f;
        }
#pragma unroll
        for (int i = 0; i < 8; ++i) {
            const int idx = tid + 512 * i, k = idx >> 6, n4 = (idx & 63) * 4;
            const f32x4 v = v8[i] * g8[i];
            float* o = sm + k * 257 + n4; o[0] = v[0]; o[1] = v[1]; o[2] = v[2]; o[3] = v[3];
        }
        __syncthreads();
#pragma unroll
        for (int i = 0; i < 4; ++i) {
            const int idx = tid + 512 * i, n = idx >> 3, kc = (idx & 7) * 8;
            const float* p = sm + kc * 257 + n;
            u32x4 w; w.x = pk2(p[0], p[257]); w.y = pk2(p[2 * 257], p[3 * 257]); w.z = pk2(p[4 * 257], p[5 * 257]); w.w = pk2(p[6 * 257], p[7 * 257]);
            *(u32x4*)(dst + (size_t)(n0 + n) * ldd + k0 + kc) = w;
        }
        __syncthreads();
    }
}
DI void p0_phase(const Params& P, int l, unsigned char* smem, const float* xsrc) {
    unsigned char* ws = P.ws(); float* sm = (float*)smem; int rot = 0;
    const float* ng = P.in(I_NORMG) + l * 1024;
    const float* win = P.in(I_WIN) + (size_t)l * 1024 * 5632;
    bf16_t* WIN = (bf16_t*)(ws + WS_WIN);
    transpose_job(win, 5632, ng, WIN, 1024, 1024, 3584, sm, rot);
    transpose_job(win + 3584, 5632, ng, WIN + (size_t)4096 * 1024, 1024, 1024, 2048, sm, rot);
    transpose_job(P.in(I_PA) + (size_t)l * 512 * 1024, 1024, nullptr, (bf16_t*)(ws + WS_WPA), 512, 512, 1024, sm, rot);
    transpose_job(P.in(I_PB) + (size_t)l * 512 * 1024, 1024, nullptr, (bf16_t*)(ws + WS_WPB), 512, 512, 1024, sm, rot);
    transpose_job(P.in(I_WOUT) + (size_t)l * 1024 * 1024, 1024, nullptr, (bf16_t*)(ws + WS_WOUT), 1024, 1024, 1024, sm, rot);
    transpose_job(P.in(I_PLEW) + (size_t)l * 1024 * 1024, 1024, P.in(I_PLEG) + l * 1024, (bf16_t*)(ws + WS_WGATE), 1024, 1024, 1024, sm, rot);
    transpose_job(P.in(I_PLEP) + (size_t)l * 256 * 1024, 1024, nullptr, (bf16_t*)(ws + WS_WPLE), 256, 256, 1024, sm, rot);
    for (int d = 0; d < 2; ++d) {
        transpose_job(P.in(I_DUP) + (size_t)(l * 2 + d) * 64 * 512, 512, nullptr, (bf16_t*)(ws + WS_UPT) + (size_t)d * 512 * 64, 64, 64, 512, sm, rot);
        transpose_job(P.in(I_IUP) + (size_t)(l * 2 + d) * 64 * 512, 512, nullptr, (bf16_t*)(ws + WS_UPT) + (size_t)(2 + d) * 512 * 64, 64, 64, 512, sm, rot);
    }
    if (l > 0) {
        const float* vd = P.in(I_VD) + (size_t)(l - 1) * 1024 * 32; const float* vu = P.in(I_VU) + (size_t)(l - 1) * 32 * 512;
        for (int idx = obid() * 512 + otid(); idx < 512 * 1024; idx += gridDim.x * 512) {
            const int n = idx >> 10, k = idx & 1023; float s = 0.f;
#pragma unroll 8
            for (int r = 0; r < 32; ++r) s += vd[k * 32 + r] * vu[r * 512 + n];
            WIN[(size_t)(3584 + n) * 1024 + k] = f2bf(s * ng[k]);
        }
    }
    if (l > 0) {
        const int wave = otid() >> 6, lane = otid() & 63;
        bf16_t* XB = (bf16_t*)(ws + WS_XB); float* ssq = (float*)(ws + WS_SSQ); const float* sq2 = (const float*)(ws + WS_DL); const bf16_t* xb16 = (const bf16_t*)xsrc;
        for (int row0 = (obid() * 8 + wave) * 4; row0 < M_; row0 += gridDim.x * 32) {
            u32x4 v[4][2]; float pr[4];
#pragma unroll
            for (int i = 0; i < 4; ++i) { v[i][0] = *(const u32x4*)(xb16 + (size_t)(row0 + i) * 1024 + lane * 8); v[i][1] = *(const u32x4*)(xb16 + (size_t)(row0 + i) * 1024 + 512 + lane * 8);
                                          pr[i] = sq2[(size_t)(row0 + i) * 16 + (lane & 15)]; }
#pragma unroll
            for (int i = 0; i < 4; ++i) {
                *(u32x4*)(XB + (size_t)(row0 + i) * 1024 + lane * 8) = v[i][0]; *(u32x4*)(XB + (size_t)(row0 + i) * 1024 + 512 + lane * 8) = v[i][1];
                float t = lane < 16 ? pr[i] : 0.f; t = wave_sum(t);
                if (lane < 16) ssq[(size_t)(row0 + i) * 16 + lane] = (lane == 0) ? t : 0.f;
            }
        }
    } else
    {
        const int wave = otid() >> 6, lane = otid() & 63;
        bf16_t* XB = (bf16_t*)(ws + WS_XB); float* ssq = (float*)(ws + WS_SSQ);
        for (int row0 = (obid() * 8 + wave) * 4; row0 < M_; row0 += gridDim.x * 32) {
            f32x4 v[4][4];
#pragma unroll
            for (int i = 0; i < 4; ++i)
#pragma unroll
                for (int j = 0; j < 4; ++j) v[i][j] = *(const f32x4*)(xsrc + (size_t)(row0 + i) * 1024 + j * 256 + lane * 4);
#pragma unroll
            for (int i = 0; i < 4; ++i) {
                float s = 0.f;
#pragma unroll
                for (int j = 0; j < 4; ++j) {
                    const f32x4 x = v[i][j];
                    s += x[0] * x[0] + x[1] * x[1] + x[2] * x[2] + x[3] * x[3];
                    u32x2 w; w.x = pk2(x[0], x[1]); w.y = pk2(x[2], x[3]);
                    *(u32x2*)(XB + (size_t)(row0 + i) * 1024 + j * 256 + lane * 4) = w;
                }
                s = wave_sum(s);
                if (lane < 16) ssq[(size_t)(row0 + i) * 16 + lane] = (lane == 0) ? s : 0.f;
            }
        }
    }
}
DI void p16_phase(const Params& P, int l) {
    const float* src = P.in(I_P) + (size_t)l * M_ * 256; bf16_t* dst = (bf16_t*)(P.ws() + WS_P16);
    const unsigned n4 = (unsigned)(M_ * 256 / 4), stride = gridDim.x * 512u;
    for (unsigned i = (unsigned)obid() * 512u + (unsigned)otid(); i < n4; i += stride * 8u) {
        f32x4 v[8];
#pragma unroll
        for (int k = 0; k < 8; ++k) { const unsigned j = i + (unsigned)k * stride; v[k] = *(const f32x4*)(src + (size_t)(j < n4 ? j : n4 - 1u) * 4); }
#pragma unroll
        for (int k = 0; k < 8; ++k) { const unsigned j = i + (unsigned)k * stride; if (j < n4) { u32x2 w; w.x = pk2(v[k][0], v[k][1]); w.y = pk2(v[k][2], v[k][3]); *(u32x2*)(dst + (size_t)j * 4) = w; } }
    }
}

constexpr int AK_LD = 72, AV_LD = 456;
DI void attn_phase(const Params& P, int l, unsigned char* smem) {
    const bf16_t* UB = (const bf16_t*)(P.ws() + WS_UB); bf16_t* OB = (bf16_t*)(P.ws() + WS_OB);
    bf16_t* Ks = (bf16_t*)smem;
    bf16_t* Vt = (bf16_t*)(smem + 448 * AK_LD * 2);
    const int tid = otid(), lane = tid & 63, w = tid >> 6, r = lane & 15, q = lane >> 4;
    const float* qg = P.in(I_QG) + l * 64; const float* kg = P.in(I_KG) + l * 64;
    const float LOG2E = 1.4426950408889634f;
    for (int unit = obid(); unit < 256; unit += gridDim.x) {
        const int b = unit >> 7, g = (unit >> 6) & 1, qb = unit & 63;
        const int t0 = qb * 128, kstart = t0 - 128;
        const bf16_t* ub = UB + (size_t)b * T_ * UB_LD;
        __syncthreads();
        {
            const int seg = tid & 7;
            float kgl[8];
#pragma unroll
            for (int e = 0; e < 8; ++e) kgl[e] = kg[seg * 8 + e];
            for (int it = 0; it < 7; ++it) {
                const int key = (tid >> 3) + 64 * it, tok = kstart + key;
                u32x4 kw = (u32x4){0u, 0u, 0u, 0u}, vw = (u32x4){0u, 0u, 0u, 0u};
                { const bool ok = (key < 384 && tok >= 0 && tok < T_); const int tcl = tok < 0 ? 0 : (tok >= T_ ? T_ - 1 : tok);
                  const u32x4 k_ = *(const u32x4*)(ub + (size_t)tcl * UB_LD + 512 + g * 64 + seg * 8), v_ = *(const u32x4*)(ub + (size_t)tcl * UB_LD + 640 + g * 64 + seg * 8);
                  if (ok) { kw = k_; vw = v_; } }
                float kf[8] = {bflo(kw.x), bfhi(kw.x), bflo(kw.y), bfhi(kw.y), bflo(kw.z), bfhi(kw.z), bflo(kw.w), bfhi(kw.w)};
                float ss = 0.f;
#pragma unroll
                for (int e = 0; e < 8; ++e) ss += kf[e] * kf[e];
                ss += __shfl_xor(ss, 1); ss += __shfl_xor(ss, 2); ss += __shfl_xor(ss, 4);
                const float rs = rsqrtf(ss * (1.0f / 64.0f) + 1e-6f);
                u32x4 o; o.x = pk2(kf[0] * rs * kgl[0], kf[1] * rs * kgl[1]); o.y = pk2(kf[2] * rs * kgl[2], kf[3] * rs * kgl[3]);
                o.z = pk2(kf[4] * rs * kgl[4], kf[5] * rs * kgl[5]); o.w = pk2(kf[6] * rs * kgl[6], kf[7] * rs * kgl[7]);
                *(u32x4*)(Ks + key * AK_LD + seg * 8) = o;
                const unsigned vv[4] = {vw.x, vw.y, vw.z, vw.w};
#pragma unroll
                for (int e = 0; e < 4; ++e) { const int ks_ = key ^ (seg << 2);
                    Vt[(seg * 8 + 2 * e) * AV_LD + ks_] = (bf16_t)(vv[e] & 0xffffu); Vt[(seg * 8 + 2 * e + 1) * AV_LD + ks_] = (bf16_t)(vv[e] >> 16); }
            }
        }
        __syncthreads();
        const int hh = w >> 1, head = g * 4 + hh;
        const float slope2 = exp2f(-(float)(head + 1)) * LOG2E;
        const float sink2 = P.in(I_SINK)[l * 8 + head] * LOG2E;
#pragma unroll
        for (int qh = 0; qh < 2; ++qh) {
        const int qoff = (w & 1) * 64 + qh * 32, q0 = t0 + qoff;
        bf16x8 Qf[2][2];
#pragma unroll
        for (int qt = 0; qt < 2; ++qt) {
            const bf16_t* qp = ub + (size_t)(q0 + qt * 16 + r) * UB_LD + head * 64;
            float qv[16]; float ss = 0.f;
#pragma unroll
            for (int ks = 0; ks < 2; ++ks) {
                const u32x4 qw = *(const u32x4*)(qp + ks * 32 + q * 8);
                qv[ks * 8 + 0] = bflo(qw.x); qv[ks * 8 + 1] = bfhi(qw.x); qv[ks * 8 + 2] = bflo(qw.y); qv[ks * 8 + 3] = bfhi(qw.y);
                qv[ks * 8 + 4] = bflo(qw.z); qv[ks * 8 + 5] = bfhi(qw.z); qv[ks * 8 + 6] = bflo(qw.w); qv[ks * 8 + 7] = bfhi(qw.w);
            }
#pragma unroll
            for (int e = 0; e < 16; ++e) ss += qv[e] * qv[e];
            ss += __shfl_xor(ss, 16); ss += __shfl_xor(ss, 32);
            const float rs = rsqrtf(ss * (1.0f / 64.0f) + 1e-6f) * 0.125f * LOG2E;
#pragma unroll
            for (int ks = 0; ks < 2; ++ks) {
                u32x4 o;
                const float* gq = qg + ks * 32 + q * 8;
                o.x = pk2(qv[ks * 8 + 0] * rs * gq[0], qv[ks * 8 + 1] * rs * gq[1]); o.y = pk2(qv[ks * 8 + 2] * rs * gq[2], qv[ks * 8 + 3] * rs * gq[3]);
                o.z = pk2(qv[ks * 8 + 4] * rs * gq[4], qv[ks * 8 + 5] * rs * gq[5]); o.w = pk2(qv[ks * 8 + 6] * rs * gq[6], qv[ks * 8 + 7] * rs * gq[7]);
                Qf[qt][ks] = __builtin_bit_cast(bf16x8, o);
            }
        }
        f32x4 O[4][2];
        float mrun[2], lrun[2];
#pragma unroll
        for (int qt = 0; qt < 2; ++qt) { mrun[qt] = sink2; lrun[qt] = (q == 0) ? 1.f : 0.f;
#pragma unroll
            for (int dt = 0; dt < 4; ++dt) O[dt][qt] = (f32x4){0.f, 0.f, 0.f, 0.f}; }
        for (int kb = 0; kb < 5; ++kb) {
            const int kl0 = qoff + kb * 64;
            f32x4 S[4][2];
            {
                bf16x8 kf[4][2];
#pragma unroll
                for (int kt = 0; kt < 4; ++kt) { kf[kt][0] = *(const bf16x8*)(Ks + (kl0 + kt * 16 + r) * AK_LD + q * 8); kf[kt][1] = *(const bf16x8*)(Ks + (kl0 + kt * 16 + r) * AK_LD + 32 + q * 8); }
                __builtin_amdgcn_sched_barrier(0);
#pragma unroll
                for (int kt = 0; kt < 4; ++kt)
#pragma unroll
                    for (int qt = 0; qt < 2; ++qt) { f32x4 a = (f32x4){0.f, 0.f, 0.f, 0.f}; a = MFMA16(kf[kt][0], Qf[qt][0], a); a = MFMA16(kf[kt][1], Qf[qt][1], a); S[kt][qt] = a; }
            }
            bf16x8 vfr[2][4];
#pragma unroll
            for (int ps = 0; ps < 2; ++ps)
#pragma unroll
                for (int dt = 0; dt < 4; ++dt) {
                    const bf16_t* vp = Vt + (dt * 16 + r) * AV_LD + kl0 + ps * 32; const int gsw = ((2 * dt + (r >> 3)) & 7) << 2;
                    const u32x2 v0 = *(const u32x2*)(vp + ((4 * q) ^ gsw)), v1 = *(const u32x2*)(vp + ((4 * q + 16) ^ gsw));
                    u32x4 vv; vv.x = v0.x; vv.y = v0.y; vv.z = v1.x; vv.w = v1.y;
                    vfr[ps][dt] = __builtin_bit_cast(bf16x8, vv);
                }
            __builtin_amdgcn_sched_barrier(0);
#pragma unroll
            for (int qt = 0; qt < 2; ++qt) {
                const int qpos = q0 + qt * 16 + r;
                float mx = -3.0e38f;
#pragma unroll
                for (int kt = 0; kt < 4; ++kt)
#pragma unroll
                    for (int j = 0; j < 4; ++j) {
                        const int kpos = kstart + kl0 + kt * 16 + 4 * q + j; int dist = qpos - kpos; dist = dist < 0 ? -dist : dist;
                        const bool valid = (dist <= 128) && (kpos >= 0) && (kpos < T_);
                        const float s = valid ? (S[kt][qt][j] - slope2 * (float)dist) : -1.0e30f;
                        S[kt][qt][j] = s; mx = fmaxf(mx, s);
                    }
                mx = fmaxf(mx, __shfl_xor(mx, 16)); mx = fmaxf(mx, __shfl_xor(mx, 32));
                const float mn = fmaxf(mrun[qt], mx), alpha = __builtin_amdgcn_exp2f(mrun[qt] - mn);
                mrun[qt] = mn; float ps = 0.f;
#pragma unroll
                for (int kt = 0; kt < 4; ++kt)
#pragma unroll
                    for (int j = 0; j < 4; ++j) { const float p = __builtin_amdgcn_exp2f(S[kt][qt][j] - mn); S[kt][qt][j] = p; ps += p; }
                lrun[qt] = lrun[qt] * alpha + ps;
#pragma unroll
                for (int dt = 0; dt < 4; ++dt) O[dt][qt] = O[dt][qt] * alpha;
            }
#pragma unroll
            for (int ps = 0; ps < 2; ++ps) {
                bf16x8 Pf[2];
#pragma unroll
                for (int qt = 0; qt < 2; ++qt) {
                    u32x4 o; o.x = pk2(S[2 * ps][qt][0], S[2 * ps][qt][1]); o.y = pk2(S[2 * ps][qt][2], S[2 * ps][qt][3]);
                    o.z = pk2(S[2 * ps + 1][qt][0], S[2 * ps + 1][qt][1]); o.w = pk2(S[2 * ps + 1][qt][2], S[2 * ps + 1][qt][3]);
                    Pf[qt] = __builtin_bit_cast(bf16x8, o);
                }
#pragma unroll
                for (int dt = 0; dt < 4; ++dt)
#pragma unroll
                    for (int qt = 0; qt < 2; ++qt) O[dt][qt] = MFMA16(vfr[ps][dt], Pf[qt], O[dt][qt]);
            }
        }
#pragma unroll
        for (int qt = 0; qt < 2; ++qt) {
            float lt = lrun[qt]; lt += __shfl_xor(lt, 16); lt += __shfl_xor(lt, 32);
            const float inv = 1.f / lt;
            const size_t row = (size_t)b * T_ + q0 + qt * 16 + r;
#pragma unroll
            for (int dt = 0; dt < 4; ++dt) {
                const int col = head * 64 + dt * 16 + 4 * q;
                const u32x2 zw = *(const u32x2*)(UB + row * UB_LD + 768 + col);
                const float z[4] = {bflo(zw.x), bfhi(zw.x), bflo(zw.y), bfhi(zw.y)};
                float o[4];
#pragma unroll
                for (int j = 0; j < 4; ++j) o[j] = O[dt][qt][j] * inv * (z[j] * sigm(z[j]));
                u32x2 ow; ow.x = pk2(o[0], o[1]); ow.y = pk2(o[2], o[3]);
                *(u32x2*)(OB + row * 512 + col) = ow;
            }
        }
        }
    }
    __syncthreads();
}

constexpr int LP = 72;
constexpr int OFF_DD = 0, OFF_ID = 9216, OFF_WR = 18432, OFF_AR = 35072, OFF_R = 51712, OFF_A = 60928, OFF_B = 70144, OFF_K = 79360, OFF_AT = 88576, OFF_KT = 97792, OFF_VT = 107008,
              OFF_GS = 116224, OFF_YS = 118272;
constexpr int OFF_P = 0, OFF_PT = 9216, OFF_T = 18432, OFF_MAK = 27648;
struct FE { float r[8], k[8], v[8], z[8], kk[8]; };

DI float ldbf(const bf16_t* base, unsigned byteoff) { return bf2f(*(const bf16_t*)((const unsigned char*)base + byteoff)); }
DI void load_shift8(const bf16_t* base, int t0, int col, float mu, float (&out)[8]) {
    float u[10];
    const int tlo = t0 > 0 ? t0 - 1 : 0, thi = t0 + 8 < T_ ? t0 + 8 : T_ - 1;
    const unsigned o0 = ((unsigned)t0 * UA_LD + (unsigned)col) * 2u;
    u[0] = ldbf(base, ((unsigned)tlo * UA_LD + (unsigned)col) * 2u); u[9] = ldbf(base, ((unsigned)thi * UA_LD + (unsigned)col) * 2u);
#pragma unroll
    for (int e = 0; e < 8; ++e) u[e + 1] = ldbf(base, o0 + (unsigned)e * (UA_LD * 2u));
    u[0] = t0 > 0 ? u[0] : 0.f; u[9] = t0 + 8 < T_ ? u[9] : 0.f;
#pragma unroll
    for (int e = 0; e < 8; ++e) out[e] = u[e + 1] + mu * (0.5f * (u[e] + u[e + 2]) - u[e + 1]);
}
DI f32x4 mm_tile_gs(const bf16_t* A, int lda, const bf16_t* Bt, int mt, int nt, int r, int q, f32x4 acc) {
#pragma unroll
    for (int ks = 0; ks < 2; ++ks) {
        const int row = nt * 16 + r;
        const bf16x8 a = *(const bf16x8*)(A + (mt * 16 + r) * lda + ks * 32 + q * 8);
        const bf16x8 b = *(const bf16x8*)(Bt + row * 64 + (((4 * ks + q) ^ ((row >> 1) & 7)) * 8));
        acc = MFMA16(a, b, acc);
    }
    return acc;
}
DI f32x4 mm_tile(const bf16_t* A, int lda, const bf16_t* Bt, int ldb, int mt, int nt, int r, int q, f32x4 acc) {
#pragma unroll
    for (int ks = 0; ks < 2; ++ks) {
        const bf16x8 a = *(const bf16x8*)(A + (mt * 16 + r) * lda + ks * 32 + q * 8);
        const bf16x8 b = *(const bf16x8*)(Bt + (nt * 16 + r) * ldb + ks * 32 + q * 8);
        acc = MFMA16(a, b, acc);
    }
    return acc;
}
#define LBAR() do { asm volatile("s_waitcnt lgkmcnt(0)" ::: "memory"); __builtin_amdgcn_s_barrier(); asm volatile("" ::: "memory"); } while (0)
struct FED { unsigned dd[4], id[4]; };
struct Frag2 { bf16x8 k0, k1; };
DI Frag2 ldf(const bf16_t* M, int ld, int tile, int r, int q) { Frag2 f; const bf16_t* p = M + (tile * 16 + r) * ld + q * 8; f.k0 = *(const bf16x8*)p; f.k1 = *(const bf16x8*)(p + 32); return f; }
DI Frag2 ldf_gs(const bf16_t* M, int tile, int r, int q) {
    Frag2 f; const int row = tile * 16 + r; const bf16_t* p = M + row * 64; const int sw = (row >> 1) & 7;
    f.k0 = *(const bf16x8*)(p + ((q ^ sw) * 8)); f.k1 = *(const bf16x8*)(p + (((4 + q) ^ sw) * 8)); return f; }
DI f32x4 mmf(const Frag2& a, const Frag2& b, f32x4 acc) { acc = MFMA16(a.k0, b.k0, acc); return MFMA16(a.k1, b.k1, acc); }
#define SCHED_FENCE() __builtin_amdgcn_sched_barrier(0)
#define Z4 ((f32x4){0.f, 0.f, 0.f, 0.f})
DI void fe_dir_load(const Params& P, int l, int b, int tc, int d, FED& o) {
    const int c = otid() & 63, g = __builtin_amdgcn_readfirstlane(otid() >> 6), t0 = tc * 64 + 8 * g;
    const bf16_t* ua = (const bf16_t*)(P.ws() + WS_UA) + (size_t)b * T_ * UA_LD;
    const float* mu = P.in(I_MU) + l * 2304;
    const int cd = 2048 + d * 64 + c, ci = 2048 + 128 + d * 64 + c;
    float td[8], ti[8];
    load_shift8(ua, t0, cd, mu[cd], td); load_shift8(ua, t0, ci, mu[ci], ti);
#pragma unroll
    for (int e = 0; e < 4; ++e) { o.dd[e] = pk2(2.f * sigm(2.f * td[2 * e]) - 1.f, 2.f * sigm(2.f * td[2 * e + 1]) - 1.f); o.id[e] = pk2(ti[2 * e], ti[2 * e + 1]); }
}
DI void fe_shared(const Params& P, int l, int b, int h, int tc, FE& f) {
    const int c = otid() & 63, g = __builtin_amdgcn_readfirstlane(otid() >> 6), t0 = tc * 64 + 8 * g, ch = h * 64 + c;
    const bf16_t* ua = (const bf16_t*)(P.ws() + WS_UA) + (size_t)b * T_ * UA_LD;
    const float* mu = P.in(I_MU) + l * 2304;
    load_shift8(ua, t0, ch, mu[ch], f.r); load_shift8(ua, t0, 512 + ch, mu[512 + ch], f.k);
    load_shift8(ua, t0, 1024 + ch, mu[1024 + ch], f.v); load_shift8(ua, t0, 1536 + ch, mu[1536 + ch], f.z);
    if (l > 0) {
        const float v0 = P.in(I_V0)[(l - 1) * 512 + ch]; const bf16_t* VF = (const bf16_t*)(P.ws() + WS_VF);
#pragma unroll
        for (int e = 0; e < 8; ++e) {
            const int tok = t0 + e; const float mix = sigm(v0 + ldbf(ua, ((unsigned)tok * UA_LD + 2304u + (unsigned)ch) * 2u));
            const float vf = ldbf(VF, (((unsigned)b * T_ + (unsigned)tok) * 512u + (unsigned)ch) * 2u); f.v[e] += (vf - f.v[e]) * mix;
        }
    }
    const float kkc = P.in(I_KK)[l * 512 + ch];
#pragma unroll
    for (int e = 0; e < 8; ++e) f.kk[e] = f.k[e] * kkc;
    {
        float ss[8];
#pragma unroll
        for (int e = 0; e < 8; ++e) ss[e] = f.kk[e] * f.kk[e];
        wave_sum8(ss);
#pragma unroll
        for (int e = 0; e < 8; ++e) f.kk[e] *= rsqrtf(fmaxf(ss[e], 1e-24f));
    }
}
constexpr int OFF_DLS = 144128;
DI void fe_dir(const Params& P, int l, int b, int h, int tc, int d, const FE& f, const FED& fd, float (&ksum)[8], unsigned char* smem, bool store_s2, u32x4& btw) {
    const int tid = otid(), c = tid & 63, g = __builtin_amdgcn_readfirstlane(tid >> 6), ch = h * 64 + c, r = c & 15, q = c >> 4;
    bf16_t* DDs = (bf16_t*)(smem + OFF_DD); bf16_t* IDs = (bf16_t*)(smem + OFF_ID); float* WRs = (float*)(smem + OFF_WR); float* ARs = (float*)(smem + OFF_AR);
    bf16_t* Rs = (bf16_t*)(smem + OFF_R); bf16_t* As = (bf16_t*)(smem + OFF_A); bf16_t* Bs = (bf16_t*)(smem + OFF_B); bf16_t* Ks = (bf16_t*)(smem + OFF_K);
    bf16_t* ATs = (bf16_t*)(smem + OFF_AT); bf16_t* KTs = (bf16_t*)(smem + OFF_KT); bf16_t* VTs = (bf16_t*)(smem + OFF_VT); float* GS = (float*)(smem + OFF_GS);
    const float w0 = P.in(I_W0)[(l * 2 + d) * 512 + ch], a0 = P.in(I_A0)[(l * 2 + d) * 512 + ch], ka = P.in(I_KA)[l * 512 + ch];
    bf16x8 bfr[4][2];
    {
        const bf16_t* upT = (const bf16_t*)(P.ws() + WS_UPT);
#pragma unroll
        for (int e = 0; e < 4; ++e) {
            const int ti = g * 4 + e, which = ti >> 4, nt = ti & 3;
            const bf16_t* Bt = upT + (size_t)(which * 2 + d) * 512 * 64 + (size_t)(h * 64) * 64;
#pragma unroll
            for (int ks = 0; ks < 2; ++ks) bfr[e][ks] = *(const bf16x8*)(Bt + (nt * 16 + r) * 64 + ks * 32 + q * 8);
        }
    }
#pragma unroll
    for (int e = 0; e < 4; ++e) { DDs[(8 * g + 2 * e) * LP + c] = (bf16_t)(fd.dd[e] & 0xffffu); DDs[(8 * g + 2 * e + 1) * LP + c] = (bf16_t)(fd.dd[e] >> 16);
                                  IDs[(8 * g + 2 * e) * LP + c] = (bf16_t)(fd.id[e] & 0xffffu); IDs[(8 * g + 2 * e + 1) * LP + c] = (bf16_t)(fd.id[e] >> 16); }
    LBAR();
    {
        const int which = g >> 2, mt = g & 3;
        const Frag2 a = ldf(which ? IDs : DDs, LP, mt, r, q);
        float* O = which ? ARs : WRs;
#pragma unroll
        for (int e = 0; e < 4; ++e) {
            f32x4 acc = MFMA16(a.k0, bfr[e][0], Z4); acc = MFMA16(a.k1, bfr[e][1], acc);
#pragma unroll
            for (int j = 0; j < 4; ++j) O[(mt * 16 + 4 * q + j) * 65 + e * 16 + r] = acc[j];
        }
    }
    LBAR();
    float lw[8], av[8], cl[8];
#pragma unroll
    for (int e = 0; e < 8; ++e) {
        const int i = 8 * g + e; const float x = -(w0 + WRs[i * 65 + c]);
        const float sp = fmaxf(x, 0.f) + __logf(1.f + __expf(-fabsf(x)));
        lw[e] = -__expf(-sp - 0.5f); av[e] = sigm(a0 + ARs[i * 65 + c]);
    }
    float s = 0.f;
    if (d == 0) {
#pragma unroll
        for (int e = 0; e < 8; ++e) { s += lw[e]; cl[e] = s; }
    } else {
#pragma unroll
        for (int e = 7; e >= 0; --e) { s += lw[e]; cl[e] = s; }
    }
    GS[g * 64 + c] = s;
    LBAR();
    float off = 0.f, tot = 0.f;
#pragma unroll
    for (int gg = 0; gg < 8; ++gg) { const float x = GS[gg * 64 + c]; tot += x; if (d == 0 ? (gg < g) : (gg > g)) off += x; }
    const int pstart = d ? (56 - 8 * g) : 8 * g;
    unsigned pa[4], pb[4], pk[4], pv[4];
#pragma unroll
    for (int e2 = 0; e2 < 4; ++e2) {
        float Av2[2], Bv2[2], Kv2[2];
#pragma unroll
        for (int u = 0; u < 2; ++u) {
            const int e = 2 * e2 + u;
            const float cs = off + cl[e];
            const float ecs = store_s2 ? 0.f : __expf(cs), encs = __expf(-cs), eprev = store_s2 ? __expf(cs - lw[e]) : 0.f;
            const float kd = f.k[e] * (1.f + (av[e] - 1.f) * ka), bd = f.kk[e] * av[e];
            const float Rv = f.r[e] * ecs, Av = -f.kk[e] * eprev, Bv = bd * encs, Kv = kd * encs;
            const int p = d ? 63 - (8 * g + e) : 8 * g + e;
            if (!store_s2) Rs[p * LP + c] = f2bf(Rv); else As[p * LP + c] = f2bf(Av);
            Bs[p * LP + c] = f2bf(Bv); Ks[p * LP + c] = f2bf(Kv);
            ksum[e] += kd;
            Av2[u] = Av; Bv2[u] = Bv; Kv2[u] = Kv;
        }
        { const unsigned wa = pk2(Av2[0], Av2[1]), wb = pk2(Bv2[0], Bv2[1]), wk = pk2(Kv2[0], Kv2[1]), wv = pk2(f.v[2 * e2], f.v[2 * e2 + 1]);
          pa[e2] = d ? __builtin_amdgcn_alignbit(wa, wa, 16) : wa; pb[e2] = d ? __builtin_amdgcn_alignbit(wb, wb, 16) : wb;
          pk[e2] = d ? __builtin_amdgcn_alignbit(wk, wk, 16) : wk; pv[e2] = d ? __builtin_amdgcn_alignbit(wv, wv, 16) : wv; }
    }
    {
        u32x4 w;
        if (store_s2) {
        w.x = d ? pa[3] : pa[0]; w.y = d ? pa[2] : pa[1]; w.z = d ? pa[1] : pa[2]; w.w = d ? pa[0] : pa[3]; *(u32x4*)(ATs + c * LP + pstart) = w;
        w.x = d ? pk[3] : pk[0]; w.y = d ? pk[2] : pk[1]; w.z = d ? pk[1] : pk[2]; w.w = d ? pk[0] : pk[3]; *(u32x4*)(KTs + c * LP + pstart) = w;
        }
        w.x = d ? pv[3] : pv[0]; w.y = d ? pv[2] : pv[1]; w.z = d ? pv[1] : pv[2]; w.w = d ? pv[0] : pv[3]; *(u32x4*)(VTs + c * LP + pstart) = w;
        if (store_s2) {
            btw.x = d ? pb[3] : pb[0]; btw.y = d ? pb[2] : pb[1]; btw.z = d ? pb[1] : pb[2]; btw.w = d ? pb[0] : pb[3];
            if (g == 0) ((float*)(smem + OFF_DLS))[c] = __expf(tot);
        }
    }
    LBAR();
}
DI void tile_out(const bf16_t* src, bf16_t* dst) { const int t = otid(), row = t >> 3, seg = t & 7; *(u32x4*)(dst + row * 64 + ((seg ^ ((row >> 1) & 7)) * 8)) = *(const u32x4*)(src + row * LP + seg * 8); }

DI void s1_phase(const Params& P, int l, unsigned char* smem) {
    const int tid = otid(), lane = tid & 63, w = __builtin_amdgcn_readfirstlane(tid >> 6), r = lane & 15, q = lane >> 4;
    bf16_t* Rs = (bf16_t*)(smem + OFF_R); bf16_t* As = (bf16_t*)(smem + OFF_A); bf16_t* Bs = (bf16_t*)(smem + OFF_B); bf16_t* Ks = (bf16_t*)(smem + OFF_K);
    bf16_t* ATs = (bf16_t*)(smem + OFF_AT); bf16_t* KTs = (bf16_t*)(smem + OFF_KT); bf16_t* VTs = (bf16_t*)(smem + OFF_VT);
    bf16_t* MAKs = (bf16_t*)(smem + OFF_MAK);
    bf16_t* PB[2] = {(bf16_t*)(smem + OFF_P), (bf16_t*)(smem + OFF_YS)};
    bf16_t* PTB[2] = {(bf16_t*)(smem + OFF_PT), Rs};
    bf16_t* TB_[2] = {(bf16_t*)(smem + OFF_T), (bf16_t*)(smem + OFF_GS + 16640 + 2048)};
    for (int item = obid(); item < 2048; item += gridDim.x) {
        const int h = (item >> 3) & 7, tci = (item & 7) + 8 * ((item >> 6) & 3) + 32 * (item >> 8), tc = tci & 127, b = tci >> 7;
        FE f; FED fd0, fd1; float ksum[8];
#pragma unroll
        for (int e = 0; e < 8; ++e) ksum[e] = 0.f;
        fe_dir_load(P, l, b, tc, 0, fd0); fe_dir_load(P, l, b, tc, 1, fd1);
        fe_shared(P, l, b, h, tc, f);
#pragma unroll
        for (int d = 0; d < 2; ++d) {
        FED fd;
#pragma unroll
        for (int e = 0; e < 4; ++e) { fd.dd[e] = fd0.dd[e]; fd.id[e] = fd0.id[e]; }
        u32x4 btw;
        fe_dir(P, l, b, h, tc, d, f, fd, ksum, smem, true, btw);
        const int which = w >> 2, mtw = w & 3;
        f32x4 macc[4];
        {
            const Frag2 a = ldf(As, LP, mtw, r, q); Frag2 bb[4];
#pragma unroll
            for (int e = 0; e < 4; ++e) bb[e] = ldf(which ? Ks : Bs, LP, e, r, q);
            SCHED_FENCE();
#pragma unroll
            for (int e = 0; e < 4; ++e) macc[e] = mmf(a, bb[e], Z4);
        }
#pragma unroll
        for (int e = 0; e < 4; ++e) {
            const int mt = mtw, nt = e; const f32x4 acc = macc[e];
#pragma unroll
            for (int j = 0; j < 4; ++j) {
                const int m = mt * 16 + 4 * q + j, n = nt * 16 + r; const float v = (n < m) ? acc[j] : 0.f;
                if (which) MAKs[m * LP + n] = f2bf(v);
                else { const bf16_t hv = f2bf(v); PB[0][m * LP + n] = hv; PTB[0][n * LP + m] = hv; TB_[0][m * LP + n] = f2bf(v + (m == n ? 1.f : 0.f)); }
            }
        }
        LBAR();
        const int mt2 = w >> 1, nt2 = (w & 1) * 2;
#define WRITE_P(SET, PN) do { _Pragma("unroll") for (int e = 0; e < 2; ++e) { const int nt = nt2 + e; \
            _Pragma("unroll") for (int j = 0; j < 4; ++j) PB[SET][(mt2 * 16 + 4 * q + j) * LP + nt * 16 + r] = f2bf(PN[e][j]); \
            u32x2 t2; t2.x = pk2(PN[e][0], PN[e][1]); t2.y = pk2(PN[e][2], PN[e][3]); *(u32x2*)(PTB[SET] + (nt * 16 + r) * LP + mt2 * 16 + 4 * q) = t2; } } while (0)
#define WRITE_T(SET, TN) do { _Pragma("unroll") for (int e = 0; e < 2; ++e) { _Pragma("unroll") for (int j = 0; j < 4; ++j) TB_[SET][(mt2 * 16 + 4 * q + j) * LP + (nt2 + e) * 16 + r] = f2bf(TN[e][j]); } } while (0)
        {
            f32x4 pn2[2];
            { const Frag2 a = ldf(PB[0], LP, mt2, r, q), b0 = ldf(PTB[0], LP, nt2, r, q), b1 = ldf(PTB[0], LP, nt2 + 1, r, q);
              SCHED_FENCE();
              pn2[0] = mmf(a, b0, Z4); pn2[1] = mmf(a, b1, Z4); }
            WRITE_P(1, pn2);
        }
        LBAR();
#pragma unroll
        for (int it = 1; it <= 5; ++it) {
            const int pc = it & 1, tc = (it - 1) & 1;
            f32x4 pn2[2], tn2[2];
            { const Frag2 ap = ldf(PB[pc], LP, mt2, r, q), at = ldf(TB_[tc], LP, mt2, r, q), b0 = ldf(PTB[pc], LP, nt2, r, q), b1 = ldf(PTB[pc], LP, nt2 + 1, r, q);
              f32x4 i0, i1;
#pragma unroll
              for (int j = 0; j < 4; ++j) { i0[j] = bf2f(TB_[tc][(mt2 * 16 + 4 * q + j) * LP + nt2 * 16 + r]); i1[j] = bf2f(TB_[tc][(mt2 * 16 + 4 * q + j) * LP + (nt2 + 1) * 16 + r]); }
              SCHED_FENCE();
              tn2[0] = mmf(at, b0, i0); tn2[1] = mmf(at, b1, i1);
              if (it < 5) { pn2[0] = mmf(ap, b0, Z4); pn2[1] = mmf(ap, b1, Z4); } }
            if (it < 5) WRITE_P(pc ^ 1, pn2);
            WRITE_T(tc ^ 1, tn2);
            LBAR();
        }
#undef WRITE_P
#undef WRITE_T
        bf16_t* Ts = TB_[1];
        bf16_t* XTs = (bf16_t*)(smem + OFF_P);
        bf16_t* BTs = (bf16_t*)(smem + OFF_PT); bf16_t* AHTs = (bf16_t*)(smem + OFF_T);
        bf16_t* OUTA = Bs; bf16_t* OUTU = As; bf16_t* OUTV = Ks; bf16_t* OUTC = ATs;
        const float* DLs = (const float*)(smem + OFF_DLS);
        { const int c = lane, pstart = d ? (56 - 8 * w) : 8 * w; *(u32x4*)(BTs + c * LP + pstart) = btw; }
        f32x4 xo2[2], ah2[2], vk2[2];
        { const Frag2 av = ldf(VTs, LP, mt2, r, q), at = ldf(Ts, LP, mt2, r, q);
          Frag2 bm[2], ba[2], bk[2];
#pragma unroll
          for (int e = 0; e < 2; ++e) { bm[e] = ldf(MAKs, LP, nt2 + e, r, q); ba[e] = ldf(ATs, LP, nt2 + e, r, q); bk[e] = ldf(KTs, LP, nt2 + e, r, q); }
          SCHED_FENCE();
#pragma unroll
          for (int e = 0; e < 2; ++e) { xo2[e] = mmf(av, bm[e], Z4); ah2[e] = mmf(at, ba[e], Z4); vk2[e] = mmf(av, bk[e], Z4); } }
#pragma unroll
        for (int e = 0; e < 2; ++e) { const int mt = mt2, nt = nt2 + e; const f32x4 x = xo2[e], ah = ah2[e], vk = vk2[e];
#pragma unroll
            for (int j = 0; j < 4; ++j) { const int o = (mt * 16 + 4 * q + j) * LP + nt * 16 + r; XTs[o] = f2bf(x[j]); OUTA[o] = f2bf(ah[j]); OUTV[o] = f2bf(vk[j]); }
            u32x2 t2; t2.x = pk2(ah[0], ah[1]); t2.y = pk2(ah[2], ah[3]); *(u32x2*)(AHTs + (nt * 16 + r) * LP + mt * 16 + 4 * q) = t2; }
        LBAR();
        f32x4 u02[2];
        { const Frag2 a = ldf(XTs, LP, mt2, r, q), b0 = ldf(Ts, LP, nt2, r, q), b1 = ldf(Ts, LP, nt2 + 1, r, q);
          SCHED_FENCE();
          u02[0] = mmf(a, b0, Z4); u02[1] = mmf(a, b1, Z4); }
#pragma unroll
        for (int e = 0; e < 2; ++e) { const int mt = mt2, nt = nt2 + e; const f32x4 u0 = u02[e];
#pragma unroll
            for (int j = 0; j < 4; ++j) OUTU[(mt * 16 + 4 * q + j) * LP + nt * 16 + r] = f2bf(u0[j]); }
        LBAR();
        f32x4 ac2[2], bc2[2]; float dlc2[2], dlm[4];
        { const Frag2 a1 = ldf(BTs, LP, mt2, r, q), a2 = ldf(OUTU, LP, mt2, r, q);
          Frag2 b1[2], b2[2]; f32x4 vk0[2];
#pragma unroll
          for (int e = 0; e < 2; ++e) { b1[e] = ldf(AHTs, LP, nt2 + e, r, q); b2[e] = ldf(BTs, LP, nt2 + e, r, q); dlc2[e] = DLs[(nt2 + e) * 16 + r];
#pragma unroll
              for (int j = 0; j < 4; ++j) vk0[e][j] = bf2f(OUTV[(mt2 * 16 + 4 * q + j) * LP + (nt2 + e) * 16 + r]); }
#pragma unroll
          for (int j = 0; j < 4; ++j) dlm[j] = DLs[mt2 * 16 + 4 * q + j];
          SCHED_FENCE();
#pragma unroll
          for (int e = 0; e < 2; ++e) { ac2[e] = mmf(a1, b1[e], Z4); bc2[e] = mmf(a2, b2[e], vk0[e]); } }
#pragma unroll
        for (int e = 0; e < 2; ++e) { const int mt = mt2, nt = nt2 + e; const f32x4 ac = ac2[e], bc = bc2[e];
            const float dlc = dlc2[e];
#pragma unroll
            for (int j = 0; j < 4; ++j) { const int m = mt * 16 + 4 * q + j, n = nt * 16 + r;
                OUTC[m * LP + n] = f2bf((ac[j] + (m == n ? 1.f : 0.f)) * dlm[j]); OUTV[m * LP + n] = f2bf(bc[j] * dlc); } }
        LBAR();
        {
            const int dh = d * 8 + h, pc = d ? 127 - tc : tc; const size_t base = ((size_t)(dh * 128 + pc)) * 4096;
            unsigned char* sc = P.scb(b); tile_out(OUTA, (bf16_t*)(sc + SC_AH) + base); tile_out(OUTU, (bf16_t*)(sc + SC_U0) + base);
            tile_out(OUTC, (bf16_t*)(sc + SC_BT) + base); tile_out(OUTV, (bf16_t*)(sc + SC_VK) + base);
        }
        LBAR();
#pragma unroll
        for (int e = 0; e < 4; ++e) { fd0.dd[e] = fd1.dd[e]; fd0.id[e] = fd1.id[e]; }
        }
    }
}

constexpr int S2_SLOT = 10240, S2_NS = 12, S2_D = 8, S2_G = 4;
DI bf16x8 mk8(u32x2 lo, u32x2 hi) { u32x4 v; v.x = lo.x; v.y = lo.y; v.z = hi.x; v.w = hi.y; return __builtin_bit_cast(bf16x8, v); }
DI void s2_issue(const unsigned char* sc, int dh, int vg, int pc, int w, int lane, unsigned char* smem) {
    const size_t cb = ((size_t)(dh * 128 + pc)) * 8192;
    PG8_LAS unsigned char* slot = (PG8_LAS unsigned char*)smem + (pc % S2_NS) * S2_SLOT;
#pragma unroll
    for (int i = 0; i < 2; ++i) {
        const int piece = 2 * (w - 1) + i;
        const unsigned char* g = (piece < 8) ? sc + SC_BT + cb + piece * 1024 : sc + SC_VK + cb + vg * 2048 + (piece - 8) * 1024;
        __builtin_amdgcn_global_load_lds((const unsigned*)(g + lane * 16), (PG8_LAS unsigned*)(slot + piece * 1024), 16, 0, 0);
    }
}
DI void s2_phase(const Params& P, unsigned char* smem) {
    if (obid() >= 128) return;
    const int bid = obid(), tid = otid(), bdh = (bid & 7) + 8 * (bid >> 5), b = bdh >> 4, dh = bdh & 15, vg = (bid >> 3) & 3,     lane = tid & 63, r = lane & 15, q = lane >> 4, w = __builtin_amdgcn_readfirstlane(tid >> 6);
    unsigned char* sc = P.scb(b);
    const bool loader = (w >= 1 && w <= 5);
    __syncthreads();
    if (loader) {
        for (int c = 0; c < S2_D; ++c) s2_issue(sc, dh, vg, c, w, lane, smem);
        asm volatile("s_waitcnt vmcnt(8)" ::: "memory");
    }
    __syncthreads();
    f32x4 S[4];
#pragma unroll
    for (int t = 0; t < 4; ++t) S[t] = (f32x4){0.f, 0.f, 0.f, 0.f};
    const int sw = (r >> 1) & 7;
    int xo[2][2], yo[4];
#pragma unroll
    for (int ks = 0; ks < 2; ++ks)
#pragma unroll
        for (int hi = 0; hi < 2; ++hi) xo[ks][hi] = r * 128 + (q & 1) * 8 + (((4 * ks + 2 * hi + (q >> 1)) ^ sw) << 4);
#pragma unroll
    for (int t = 0; t < 4; ++t) yo[t] = r * 128 + (q & 1) * 8 + (((2 * t + (q >> 1)) ^ sw) << 4);
    const int go = (16 * vg + r) * 64 + (q & 1) * 4;
#pragma unroll 1
    for (int pc = 0; pc < 128; pc += S2_G) {
        if (loader) {
            if (pc + S2_D < 128) {
#pragma unroll
                for (int c = 0; c < S2_G; ++c) s2_issue(sc, dh, vg, pc + S2_D + c, w, lane, smem);
                asm volatile("s_waitcnt vmcnt(8)" ::: "memory");
            }
            else asm volatile("s_waitcnt vmcnt(0)" ::: "memory");
        } else if (w == 0) {
            u32x2 fa[S2_G][4][2][2], fv[S2_G][4];
#pragma unroll
            for (int c2 = 0; c2 < S2_G; ++c2) {
                const unsigned char* sl = smem + ((pc + c2) % S2_NS) * S2_SLOT;
#pragma unroll
                for (int t = 0; t < 4; ++t) {
#pragma unroll
                    for (int ks = 0; ks < 2; ++ks)
#pragma unroll
                        for (int hi = 0; hi < 2; ++hi) fa[c2][t][ks][hi] = *(const u32x2*)(sl + t * 2048 + xo[ks][hi]);
                    fv[c2][t] = *(const u32x2*)(sl + 8192 + yo[t]);
                }
            }
#pragma unroll
            for (int c2 = 0; c2 < S2_G; ++c2) {
                bf16_t* S0g = (bf16_t*)(sc + SC_VK) + ((size_t)(dh * 128 + pc + c2)) * 4096;
                u32x2 sb[4];
#pragma unroll
                for (int t = 0; t < 4; ++t) { sb[t].x = pk2(S[t][0], S[t][1]); sb[t].y = pk2(S[t][2], S[t][3]); }
#pragma unroll
                for (int t = 0; t < 4; ++t) {
                    f32x4 a = (f32x4){bflo(fv[c2][t].x), bfhi(fv[c2][t].x), bflo(fv[c2][t].y), bfhi(fv[c2][t].y)};
#pragma unroll
                    for (int ks = 0; ks < 2; ++ks) a = MFMA16(mk8(fa[c2][t][ks][0], fa[c2][t][ks][1]), mk8(sb[2 * ks], sb[2 * ks + 1]), a);
                    S[t] = a;
                }
#pragma unroll
                for (int t = 0; t < 4; ++t) *(u32x2*)(S0g + go + (((2 * t + (q >> 1)) ^ sw) << 3)) = sb[t];
            }
        }
        asm volatile("" ::: "memory"); __builtin_amdgcn_s_barrier(); asm volatile("" ::: "memory");
    }
    asm volatile("s_waitcnt vmcnt(0) lgkmcnt(0)" ::: "memory");
    __syncthreads();
}

struct RAW3 { unsigned u[6][10]; float mu[6]; float kkc; };
DI unsigned raw16(const bf16_t* base, unsigned byteoff) { return *(const bf16_t*)((const unsigned char*)base + byteoff); }
DI void raw3_issue(const Params& P, int l, int item, RAW3& R) {
    const int h = (item >> 3) & 7, tci = (item & 7) + 8 * ((item >> 6) & 3) + 32 * (item >> 8), tc = tci & 127, b = tci >> 7;
    const int c = otid() & 63, g = __builtin_amdgcn_readfirstlane(otid() >> 6), t0 = tc * 64 + 8 * g, ch = h * 64 + c;
    const bf16_t* ua = (const bf16_t*)(P.ws() + WS_UA) + (size_t)b * T_ * UA_LD;
    const float* mu = P.in(I_MU) + l * 2304;
    const int tlo = t0 > 0 ? t0 - 1 : 0, thi = t0 + 8 < T_ ? t0 + 8 : T_ - 1;
    const int cols[6] = {ch, 512 + ch, 1024 + ch, 1536 + ch, 2048 + c, 2048 + 128 + c};
#pragma unroll
    for (int gi = 0; gi < 6; ++gi) {
        const unsigned col = (unsigned)cols[gi], o0 = ((unsigned)t0 * UA_LD + col) * 2u;
        R.u[gi][0] = raw16(ua, ((unsigned)tlo * UA_LD + col) * 2u); R.u[gi][9] = raw16(ua, ((unsigned)thi * UA_LD + col) * 2u);
#pragma unroll
        for (int e = 0; e < 8; ++e) R.u[gi][e + 1] = raw16(ua, o0 + (unsigned)e * (UA_LD * 2u));
        R.mu[gi] = mu[col];
    }
    R.kkc = P.in(I_KK)[l * 512 + ch];
}
DI void raw3_shift(const RAW3& R, int gi, int t0, float (&out)[8]) {
    float u[10];
#pragma unroll
    for (int e = 0; e < 10; ++e) u[e] = __uint_as_float(R.u[gi][e] << 16);
    u[0] = t0 > 0 ? u[0] : 0.f; u[9] = t0 + 8 < T_ ? u[9] : 0.f;
#pragma unroll
    for (int e = 0; e < 8; ++e) out[e] = u[e + 1] + R.mu[gi] * (0.5f * (u[e] + u[e + 2]) - u[e + 1]);
}
DI void raw3_consume(const Params& P, const RAW3& R, int l, int b, int h, int tc, FE& f, FED& fd0) {
    const int g = __builtin_amdgcn_readfirstlane(otid() >> 6), t0 = tc * 64 + 8 * g;
    raw3_shift(R, 0, t0, f.r); raw3_shift(R, 1, t0, f.k); raw3_shift(R, 2, t0, f.v); raw3_shift(R, 3, t0, f.z);
    {
        float td[8], ti[8];
        raw3_shift(R, 4, t0, td); raw3_shift(R, 5, t0, ti);
#pragma unroll
        for (int e = 0; e < 4; ++e) { fd0.dd[e] = pk2(2.f * sigm(2.f * td[2 * e]) - 1.f, 2.f * sigm(2.f * td[2 * e + 1]) - 1.f); fd0.id[e] = pk2(ti[2 * e], ti[2 * e + 1]); }
    }
    if (l > 0) {
        const int c = otid() & 63, ch = h * 64 + c;
        const bf16_t* ua = (const bf16_t*)(P.ws() + WS_UA) + (size_t)b * T_ * UA_LD; const bf16_t* VF = (const bf16_t*)(P.ws() + WS_VF);
        const float v0 = P.in(I_V0)[(l - 1) * 512 + ch];
#pragma unroll
        for (int e = 0; e < 8; ++e) {
            const unsigned tok = (unsigned)(t0 + e); const float mix = sigm(v0 + ldbf(ua, (tok * UA_LD + 2304u + (unsigned)ch) * 2u));
            const float vf = ldbf(VF, (((unsigned)b * T_ + tok) * 512u + (unsigned)ch) * 2u); f.v[e] += (vf - f.v[e]) * mix;
        }
    }
#pragma unroll
    for (int e = 0; e < 8; ++e) f.kk[e] = f.k[e] * R.kkc;
    {
        float ss[8];
#pragma unroll
        for (int e = 0; e < 8; ++e) ss[e] = f.kk[e] * f.kk[e];
        wave_sum8(ss);
#pragma unroll
        for (int e = 0; e < 8; ++e) f.kk[e] *= rsqrtf(fmaxf(ss[e], 1e-24f));
    }
}

DI void s3_phase(const Params& P, int l, unsigned char* smem) {
    const int tid = otid(), lane = tid & 63, w = __builtin_amdgcn_readfirstlane(tid >> 6), r = lane & 15, q = lane >> 4;
    bf16_t* Rs = (bf16_t*)(smem + OFF_R); bf16_t* Bs = (bf16_t*)(smem + OFF_B); bf16_t* Ks = (bf16_t*)(smem + OFF_K); bf16_t* VTs = (bf16_t*)(smem + OFF_VT);
    bf16_t* MRB = (bf16_t*)(smem + OFF_WR); bf16_t* MRK = (bf16_t*)(smem + OFF_AR); float* YS = (float*)(smem + OFF_YS);
    RAW3 R;
    { const int first = obid(); if (first < 2048) raw3_issue(P, l, first, R); }
    for (int item = obid(); item < 2048; item += gridDim.x) {
        const int h = (item >> 3) & 7, tci = (item & 7) + 8 * ((item >> 6) & 3) + 32 * (item >> 8), tc = tci & 127, b = tci >> 7;
        FE f; FED fd0, fd1; float ksum[8];
#pragma unroll
        for (int e = 0; e < 8; ++e) ksum[e] = 0.f;
        fe_dir_load(P, l, b, tc, 1, fd1);
        const float lnw = P.in(I_LNW)[l * 512 + h * 64 + lane], lnb = P.in(I_LNB)[l * 512 + h * 64 + lane], rk = P.in(I_RK)[l * 512 + h * 64 + lane];
        raw3_consume(P, R, l, b, h, tc, f, fd0);
#pragma unroll
        for (int d = 0; d < 2; ++d) {
            FED fd;
#pragma unroll
            for (int e = 0; e < 4; ++e) { fd.dd[e] = fd0.dd[e]; fd.id[e] = fd0.id[e]; }
            u32x4 btw;
            fe_dir(P, l, b, h, tc, d, f, fd, ksum, smem, false, btw);
            if (d == 1 && item + (int)gridDim.x < 2048) raw3_issue(P, l, item + (int)gridDim.x, R);
            const int which = w >> 2, mtw = w & 3, mt2 = w >> 1, nt2 = (w & 1) * 2;
            const int dh = d * 8 + h, pc = d ? 127 - tc : tc; const size_t base = ((size_t)(dh * 128 + pc)) * 4096;
            const bf16_t* U0T = (const bf16_t*)(P.scb(b) + SC_U0) + base; const bf16_t* S0 = (const bf16_t*)(P.scb(b) + SC_VK) + base; const bf16_t* AH = (const bf16_t*)(P.scb(b) + SC_AH) + base;
            const Frag2 gah = ldf_gs(AH, mt2, r, q), gs0 = ldf_gs(S0, nt2, r, q), gs1 = ldf_gs(S0, nt2 + 1, r, q);
            u32x2 gu0[2];
#pragma unroll
            for (int e = 0; e < 2; ++e) { const int vrow = (nt2 + e) * 16 + r; gu0[e] = *(const u32x2*)(U0T + vrow * 64 + (((2 * mt2 + (q >> 1)) ^ ((vrow >> 1) & 7)) << 3) + (q & 1) * 4); }
            f32x4 macc[4];
            { const Frag2 a = ldf(Rs, LP, mtw, r, q); Frag2 bb[4];
#pragma unroll
              for (int e = 0; e < 4; ++e) bb[e] = ldf(which ? Ks : Bs, LP, e, r, q);
              SCHED_FENCE();
#pragma unroll
              for (int e = 0; e < 4; ++e) macc[e] = mmf(a, bb[e], Z4); }
#pragma unroll
            for (int e = 0; e < 4; ++e) {
                const int mt = mtw, nt = e; const f32x4 acc = macc[e];
                bf16_t* O = which ? MRK : MRB;
#pragma unroll
                for (int j = 0; j < 4; ++j) { const int m = mt * 16 + 4 * q + j, n = nt * 16 + r; O[m * LP + n] = f2bf((n <= m) ? acc[j] : 0.f); }
            }
            bf16_t* UTs = (bf16_t*)(smem + OFF_AT);
#pragma unroll
            for (int e = 0; e < 2; ++e) {
                const f32x4 u = mmf(gah, e ? gs1 : gs0, (f32x4){bflo(gu0[e].x), bfhi(gu0[e].x), bflo(gu0[e].y), bfhi(gu0[e].y)});
                u32x2 t2; t2.x = pk2(u[0], u[1]); t2.y = pk2(u[2], u[3]); *(u32x2*)(UTs + ((nt2 + e) * 16 + r) * LP + mt2 * 16 + 4 * q) = t2;
            }
            LBAR();
            f32x4 y2[2];
            { const Frag2 a1 = ldf(MRK, LP, mt2, r, q), a2 = ldf(MRB, LP, mt2, r, q), a3 = ldf(Rs, LP, mt2, r, q);
              Frag2 b1[2], b2[2];
#pragma unroll
              for (int e = 0; e < 2; ++e) { b1[e] = ldf(VTs, LP, nt2 + e, r, q); b2[e] = ldf(UTs, LP, nt2 + e, r, q); }
              SCHED_FENCE();
#pragma unroll
              for (int e = 0; e < 2; ++e) { f32x4 y = mmf(a1, b1[e], Z4); y = mmf(a2, b2[e], y); y2[e] = mmf(a3, e ? gs1 : gs0, y); } }
#pragma unroll
            for (int e = 0; e < 2; ++e) {
                const int mt = mt2, nt = nt2 + e; const f32x4 y = y2[e];
#pragma unroll
                for (int j = 0; j < 4; ++j) { const int p = mt * 16 + 4 * q + j, v = nt * 16 + r;
                    if (d == 0) YS[p * 65 + v] = y[j]; else YS[(63 - p) * 65 + v] += y[j]; }
            }
            LBAR();
#pragma unroll
            for (int e = 0; e < 4; ++e) { fd0.dd[e] = fd1.dd[e]; fd0.id[e] = fd1.id[e]; }
        }
        {
            const int c = lane, g = w, ch = h * 64 + c;
            bf16_t* OA = (bf16_t*)(P.ws() + WS_OA); bf16_t* VF = (bf16_t*)(P.ws() + WS_VF);
            float y8[8], s1[8], s2[8], s3[8];
#pragma unroll
            for (int e = 0; e < 8; ++e) { const float y = YS[(8 * g + e) * 65 + c]; y8[e] = y; s1[e] = y; s2[e] = y * y; s3[e] = f.r[e] * ksum[e] * rk; }
            wave_sum8(s1); wave_sum8(s2); wave_sum8(s3);
#pragma unroll
            for (int e = 0; e < 8; ++e) {
                const int i = 8 * g + e; const size_t row = (size_t)b * T_ + tc * 64 + i;
                const float mean = s1[e] * (1.f / 64.f), var = fmaxf(s2[e] * (1.f / 64.f) - mean * mean, 0.f);
                const float yn = (y8[e] - mean) * rsqrtf(var + 64e-5f) * lnw + lnb;
                const float bon = s3[e] * f.v[e];
                const float z = f.z[e];
                const unsigned ob = ((unsigned)row * 512u + (unsigned)ch) * 2u;
                *(bf16_t*)((unsigned char*)OA + ob) = f2bf((yn + bon) * (z * sigm(z)));
                if (l == 0) *(bf16_t*)((unsigned char*)VF + ob) = f2bf(f.v[e]);
            }
        }
        LBAR();
    }
}

#define RLX_AGENT __ATOMIC_RELAXED, __HIP_MEMORY_SCOPE_AGENT
#define XB_TMO      128
#define XB_XCNT(j)  (256  + 64 * (j))
#define XB_XSUB(j)  (1280 + 64 * (j))
#define XB_XGEN(j)  (2304 + 64 * (j))
#define XB_TOP      3328
#define XB_TOPGEN   3392
#define XCD_BAR_WORDS 3456
#define XB_SPIN_CAP (1u << 18)

__device__ __forceinline__ unsigned xb_ld(unsigned* p)              { return __hip_atomic_load(p, __ATOMIC_RELAXED, __HIP_MEMORY_SCOPE_AGENT); }
__device__ __forceinline__ unsigned xb_add(unsigned* p, unsigned v) { return __hip_atomic_fetch_add(p, v, __ATOMIC_RELAXED, __HIP_MEMORY_SCOPE_AGENT); }
__device__ __forceinline__ unsigned xb_xcc_id() { return (unsigned)__builtin_amdgcn_s_getreg((3 << 11) | 20) & 0xFu; }
#define XB_SPIN(cond, bar) do { unsigned _sp = 0; while (cond) { __builtin_amdgcn_s_sleep(1); \
    if ((++_sp & 255u) == 0u) { if (xb_ld(&(bar)[XB_TMO])) break; if (_sp > XB_SPIN_CAP) { atomicAdd(&(bar)[XB_TMO], 1u); break; } } } } while (0)

struct XcdBarrier {
    unsigned* bar; unsigned x;
    volatile __attribute__((address_space(3))) unsigned* st;
};

__device__ __forceinline__ XcdBarrier xcd_barrier_post(unsigned* bar, volatile __attribute__((address_space(3))) unsigned* st) {
    XcdBarrier b; b.bar = bar; b.x = xb_xcc_id(); b.st = st;
    if (threadIdx.x == 0) (void)xb_add(&bar[XB_XCNT(b.x)], 1u);
    return b;
}
__device__ __forceinline__ void xcd_barrier_complete(unsigned* bar, unsigned x, unsigned& nloc, unsigned& nx) {
    const unsigned G = gridDim.x * gridDim.y * gridDim.z;
    unsigned sum, cnt, mine, sp = 0u;
    for (;;) {
        sum = 0u; cnt = 0u; mine = 0u;
#pragma unroll
        for (unsigned j = 0; j < 16; ++j) { const unsigned c = xb_ld(&bar[XB_XCNT(j)]); sum += c; cnt += (c > 0u) ? 1u : 0u; mine = (j == x) ? c : mine; }
        if (sum == G) break;
        __builtin_amdgcn_s_sleep(1);
        if ((++sp & 255u) == 0u) { if (xb_ld(&bar[XB_TMO])) break; if (sp > XB_SPIN_CAP) { atomicAdd(&bar[XB_TMO], 1u); break; } }
    }
    nloc = mine > 0u ? mine : 1u; nx = cnt > 0u ? cnt : 1u;
}

__device__ __forceinline__ void xcd_barrier(const XcdBarrier& b) {
    asm volatile("s_waitcnt vmcnt(0)" ::: "memory");
    __syncthreads();
    if (threadIdx.x == 0) {
        unsigned* bar = b.bar;
        __builtin_amdgcn_s_waitcnt(0);
        unsigned nloc = b.st[0], nx = b.st[1];
        if (nloc == 0u) { xcd_barrier_complete(bar, b.x, nloc, nx); b.st[0] = nloc; b.st[1] = nx; }
        const unsigned old = xb_add(&bar[XB_XSUB(b.x)], 1u);
        const unsigned gen = old / nloc;
        if (old + 1u == (gen + 1u) * nloc) {
            __builtin_amdgcn_fence(__ATOMIC_RELEASE, "agent");
            asm volatile("s_waitcnt vmcnt(0)" ::: "memory");
            const unsigned og = xb_add(&bar[XB_TOP], 1u);
            const unsigned tg = og / nx;
            if (og + 1u == (tg + 1u) * nx) xb_add(&bar[XB_TOPGEN], 1u);
            else XB_SPIN(xb_ld(&bar[XB_TOPGEN]) == tg, bar);
            __builtin_amdgcn_fence(__ATOMIC_ACQUIRE, "agent");
            xb_add(&bar[XB_XGEN(b.x)], 1u);
            asm volatile("s_waitcnt vmcnt(0)" ::: "memory");
        } else {
            XB_SPIN(xb_ld(&bar[XB_XGEN(b.x)]) == gen, bar);
            __builtin_amdgcn_fence(__ATOMIC_ACQUIRE, "agent");
            asm volatile("s_waitcnt vmcnt(0)" ::: "memory");
        }
    }
    __syncthreads();
}

DI void gbar(unsigned* ctr, unsigned target) {
    asm volatile("s_waitcnt vmcnt(0)" ::: "memory");
    __syncthreads();
    if (threadIdx.x == 0) {
        __builtin_amdgcn_fence(__ATOMIC_RELEASE, "agent");
        asm volatile("s_waitcnt vmcnt(0)" ::: "memory");
        __hip_atomic_fetch_add(ctr, 1u, __ATOMIC_RELAXED, __HIP_MEMORY_SCOPE_AGENT);
        while (__hip_atomic_load(ctr, __ATOMIC_RELAXED, __HIP_MEMORY_SCOPE_AGENT) < target) __builtin_amdgcn_s_sleep(1);
        __builtin_amdgcn_fence(__ATOMIC_ACQUIRE, "agent");
        asm volatile("s_waitcnt vmcnt(0)" ::: "memory");
    }
    __syncthreads();
}
__global__ void __launch_bounds__(512, 2) fwd_megakernel(KArgs KA) {
    extern __shared__ __attribute__((aligned(16))) unsigned char smem[];
    if (threadIdx.x == 0) {
        unsigned long long* pt = (unsigned long long*)(smem + PARAMS_OFF);
#pragma unroll
        for (int i = 0; i < 26; ++i) pt[i] = (unsigned long long)KA.in[i];
        pt[26] = (unsigned long long)KA.out; pt[27] = (unsigned long long)KA.ws;
    }
    __syncthreads();
    Params P{smem};
    XcdBarrier xbar;
    {
        volatile __attribute__((address_space(3))) unsigned* st = (volatile __attribute__((address_space(3))) unsigned*)((__attribute__((address_space(3))) unsigned char*)smem + PARAMS_OFF + 232);
        if (threadIdx.x == 0) { st[0] = 0u; st[1] = 0u; }
        __syncthreads();
        xbar = xcd_barrier_post((unsigned*)(KA.ws + WS_BAR), st);
    }
    unsigned bar_target = 0;
#define GSYNC() xcd_barrier(xbar)
#define WSP() unsigned char* ws = P.ws(); float* ssq = (float*)(ws + WS_SSQ); bf16_t* XB = (bf16_t*)(ws + WS_XB); (void)ssq; (void)XB
#ifndef PHMASK
#define PHMASK 0xffff
#endif
#define PH(k) if (PHMASK & (1 << (k)))
    static_assert(NLAYER == 2, "the layer program below is written out twice");
    { constexpr int l = 0;

        PH(0) p0_phase(P, l, smem, (l == 0) ? P.in(I_X) : P.out());
        GSYNC();
        PH(1) { WSP(); Epi<EP_U> E{ssq, (bf16_t*)(ws + WS_UA), (bf16_t*)(ws + WS_UB), nullptr, nullptr, nullptr, nullptr};
          run_gemm<EP_U>(smem, XB, (const bf16_t*)(ws + WS_WIN), l == 0 ? 3584 : 4096, 1024, E); }
        GSYNC();
        PH(2) attn_phase(P, l, smem);
        GSYNC();
        PH(3) s1_phase(P, l, smem);
        GSYNC();
        PH(4) s2_phase(P, smem);
        GSYNC();
        PH(5) s3_phase(P, l, smem);
        GSYNC();
        PH(6) { WSP(); Epi<EP_GATE> E{ssq, (bf16_t*)(ws + WS_GATES), nullptr, nullptr, nullptr, nullptr, nullptr};
          run_gemm<EP_GATE>(smem, XB, (const bf16_t*)(ws + WS_WIN) + (size_t)4096 * 1024, 2048, 1024, E); }
        PH(0) p16_phase(P, l);
        GSYNC();
        PH(7) { WSP(); static_assert(WS_OA == WS_OB + (size_t)M_ * 512 * 2 && WS_WPB == WS_WPA + (size_t)1024 * 512 * 2, "stacked operands");
          Epi<EP_PAB> E{nullptr, (bf16_t*)(ws + WS_MERGED), nullptr, (const bf16_t*)(ws + WS_GATES), nullptr, nullptr, nullptr};
          run_gemm_pair(smem, (const bf16_t*)(ws + WS_OB), (const bf16_t*)(ws + WS_WPA), E); }
        GSYNC();
        PH(9) { WSP(); Epi<EP_PLE> E{nullptr, (bf16_t*)(ws + WS_PLE), nullptr, nullptr, nullptr, nullptr, nullptr};
          run_gemm<EP_PLE>(smem, (const bf16_t*)(ws + WS_P16), (const bf16_t*)(ws + WS_WPLE), 1024, 256, E); }
        PH(10) { WSP(); Epi<EP_OUT> E{nullptr, XB, nullptr, nullptr, (l == 0) ? P.in(I_X) : nullptr, P.out(), ssq};
          run_gemm<EP_OUT>(smem, (const bf16_t*)(ws + WS_MERGED), (const bf16_t*)(ws + WS_WOUT), 1024, 1024, E); }
        GSYNC();
        PH(11) { WSP(); Epi<EP_FIN> E{ssq, XB, (bf16_t*)P.out(), (const bf16_t*)(ws + WS_PLE), nullptr, P.out(), (float*)(ws + WS_DL)};
          run_gemm<EP_FIN>(smem, XB, (const bf16_t*)(ws + WS_WGATE), 1024, 1024, E); }
        if (l + 1 < NLAYER) GSYNC();
    }
    { constexpr int l = 1;

        PH(0) p0_phase(P, l, smem, (l == 0) ? P.in(I_X) : P.out());
        GSYNC();
        PH(1) { WSP(); Epi<EP_U> E{ssq, (bf16_t*)(ws + WS_UA), (bf16_t*)(ws + WS_UB), nullptr, nullptr, nullptr, nullptr};
          run_gemm<EP_U>(smem, XB, (const bf16_t*)(ws + WS_WIN), l == 0 ? 3584 : 4096, 1024, E); }
        GSYNC();
        PH(2) attn_phase(P, l, smem);
        GSYNC();
        PH(3) s1_phase(P, l, smem);
        GSYNC();
        PH(4) s2_phase(P, smem);
        GSYNC();
        PH(5) s3_phase(P, l, smem);
        GSYNC();
        PH(6) { WSP(); Epi<EP_GATE> E{ssq, (bf16_t*)(ws + WS_GATES), nullptr, nullptr, nullptr, nullptr, nullptr};
          run_gemm<EP_GATE>(smem, XB, (const bf16_t*)(ws + WS_WIN) + (size_t)4096 * 1024, 2048, 1024, E); }
        PH(0) p16_phase(P, l);
        GSYNC();
        PH(7) { WSP(); static_assert(WS_OA == WS_OB + (size_t)M_ * 512 * 2 && WS_WPB == WS_WPA + (size_t)1024 * 512 * 2, "stacked operands");
          Epi<EP_PAB> E{nullptr, (bf16_t*)(ws + WS_MERGED), nullptr, (const bf16_t*)(ws + WS_GATES), nullptr, nullptr, nullptr};
          run_gemm_pair(smem, (const bf16_t*)(ws + WS_OB), (const bf16_t*)(ws + WS_WPA), E); }
        GSYNC();
        PH(9) { WSP(); Epi<EP_PLE> E{nullptr, (bf16_t*)(ws + WS_PLE), nullptr, nullptr, nullptr, nullptr, nullptr};
          run_gemm<EP_PLE>(smem, (const bf16_t*)(ws + WS_P16), (const bf16_t*)(ws + WS_WPLE), 1024, 256, E); }
        PH(10) { WSP(); Epi<EP_OUT> E{nullptr, XB, nullptr, nullptr, (l == 0) ? P.in(I_X) : nullptr, P.out(), ssq};
          run_gemm<EP_OUT>(smem, (const bf16_t*)(ws + WS_MERGED), (const bf16_t*)(ws + WS_WOUT), 1024, 1024, E); }
        GSYNC();
        PH(11) { WSP(); Epi<EP_FIN> E{ssq, XB, nullptr, (const bf16_t*)(ws + WS_PLE), nullptr, P.out(), nullptr};
          run_gemm<EP_FIN>(smem, XB, (const bf16_t*)(ws + WS_WGATE), 1024, 1024, E); }
        if (l + 1 < NLAYER) GSYNC();
    }
}

extern "C" void kernel_launch(void* const* d_in, const int* in_sizes, int n_in, void* d_out, int out_size, void* d_ws, size_t ws_size, hipStream_t stream) {
    static int grid = 0;
    if (grid == 0) {
        if (n_in != 26 || ws_size < WS_END) { fprintf(stderr, "kernel_launch: unexpected n_in %d / ws_size %zu\n", n_in, ws_size); grid = -1; return; }
        int dev = 0, cus = 0, per_cu = 0;
        hipGetDevice(&dev); hipDeviceGetAttribute(&cus, hipDeviceAttributeMultiprocessorCount, dev);
        hipFuncSetAttribute((const void*)fwd_megakernel, hipFuncAttributeMaxDynamicSharedMemorySize, LDS_BYTES);
        hipOccupancyMaxActiveBlocksPerMultiprocessor(&per_cu, (const void*)fwd_megakernel, 512, LDS_BYTES);
        if (per_cu < 1) { fprintf(stderr, "kernel_launch: occupancy query says %d\n", per_cu); per_cu = 1; }
        if (per_cu > 1) per_cu = 1;
        grid = cus * per_cu;
    }
    if (grid < 0) return;
    KArgs p{};
    for (int i = 0; i < 26; ++i) p.in[i] = (const float*)d_in[i];
    p.out = (float*)d_out; p.ws = (unsigned char*)d_ws;
    hipMemsetAsync((unsigned char*)d_ws + WS_BAR, 0, XCD_BAR_WORDS * 4, stream);
    void* args[] = {&p};
    hipError_t e = hipLaunchCooperativeKernel((void*)fwd_megakernel, dim3(grid), dim3(512), args, LDS_BYTES, stream);
    if (e != hipSuccess) fprintf(stderr, "cooperative launch failed: %s (grid %d)\n", hipGetErrorString(e), grid);
}
```

```cpp
#include <hip/hip_runtime.h>
#include <hip/hip_cooperative_groups.h>
#include <cstdio>
#include <cstdint>
namespace cg = cooperative_groups;

#define DI __device__ __forceinline__
typedef unsigned short bf16_t;
typedef short bf16x8 __attribute__((ext_vector_type(8)));
typedef short bf16x4 __attribute__((ext_vector_type(4)));
typedef float f32x4 __attribute__((ext_vector_type(4)));
typedef unsigned u32x4 __attribute__((ext_vector_type(4)));
typedef unsigned u32x2 __attribute__((ext_vector_type(2)));


DI int otid() { int t = threadIdx.x; asm volatile("" : "+v"(t)); return t; }
DI int obid() { int b = blockIdx.x; asm volatile("" : "+s"(b)); return b; }
namespace pg8 {
#define PG8_LAS __attribute__((address_space(3)))
constexpr int BM = 256, BK = 64, HALF = 128, HTB = HALF * BK * 2, STAGE_BYTES = 8 * HTB, NXCD = 8, WGM = 8;
__host__ __device__ __forceinline__ int lds_byte(int r, int c) { const int st = (r >> 4) * 2 + (c >> 5), rr = r & 15, cc = c & 31, ob = rr * 64 + cc * 2; return st * 1024 + (ob ^ (((ob >> 9) & 1) << 5)); }
__host__ __device__ __forceinline__ void stage_rc(int b, int& R, int& C) { const int st = b / 1024, sb = b % 1024, swz = sb ^ (((sb >> 9) & 1) << 5); R = (st >> 1) * 16 + swz / 64; C = (st & 1) * 32 + (swz % 64) / 2; }
__host__ __device__ __forceinline__ int perm32(int rho) { const int n = rho >> 4, i = rho & 15; return 8 * (i >> 2) + 4 * n + (i & 3); }
struct Unit { int pm, pn; };
struct Gemm { const bf16_t* A; const bf16_t* Bt; int M, N, K; };
struct StaticOrder {
    int nM, nN, nwg, G, c;
    __host__ __device__ void init(int M, int N, int G_, int c_) { nM = M / BM; nN = N / BM; nwg = nM * nN; G = G_; c = c_; }
    __host__ __device__ bool next(int i, Unit& u) const {
        const long L = (long)i * G + c; if (L >= nwg) return false;
        int wgid = (int)L; { const int q = nwg / NXCD, r = nwg % NXCD, xcd = wgid % NXCD, off = wgid / NXCD; wgid = (xcd < r ? xcd * (q + 1) : r * (q + 1) + (xcd - r) * q) + off; }
        const int nig = WGM * nN, gid = wgid / nig, fm = gid * WGM, gsz = (nM - fm) < WGM ? (nM - fm) : WGM;
        u.pm = fm + ((wgid % nig) % gsz); u.pn = (wgid % nig) / gsz; return true;
    }
    __device__ __forceinline__ void a_ready(const Unit&) const {}
    __device__ __forceinline__ void done(const Unit&) const {}
};
__device__ __forceinline__ unsigned cvt_pk_bf16(float lo, float hi) { unsigned r; asm volatile("v_cvt_pk_bf16_f32 %0, %1, %2" : "=v"(r) : "v"(lo), "v"(hi)); return r; }
template <class Epi, class Sched, bool ALIGN_EPI = false, bool SP2 = false>
__device__ __forceinline__ void gemm_phase(PG8_LAS unsigned char* lds, const Gemm g, const Sched& S, const Epi& E) {
    const int tid = otid(), wid = __builtin_amdgcn_readfirstlane(tid >> 6), lane = tid & 63, wr = wid >> 2, wc = wid & 3, fr = lane & 15, fq = lane >> 4;
    const int K = g.K, nt = K / BK;
    unsigned voffA[2], voffB[2];
#pragma unroll
    for (int i = 0; i < 2; ++i) { int R, C; stage_rc(tid * 16 + i * 8192, R, C); const int Rb = Epi::PERM ? ((R & ~31) + perm32(R & 31)) : R;
        voffA[i] = (unsigned)(R * K + C) * 2u; voffB[i] = (unsigned)(Rb * K + C) * 2u; }
    const size_t kstep = (size_t)(BK * 2);
    const size_t hstep = (size_t)HALF * K * 2;
    const size_t tstep = 2 * hstep;
    const unsigned ldsw = (unsigned)wid * 1024u;
    const int aoff = lds_byte(wr * 64 + fr, fq * 8), boff = lds_byte(wc * 32 + fr, fq * 8);
#define PG8_SA(b, h) (((b) * 2 + (h)) * HTB)
#define PG8_SB(b, h) ((4 + (b) * 2 + (h)) * HTB)
#define PG8_STAGE(bufoff, gbase, voff) do { _Pragma("unroll") for (int _i = 0; _i < 2; ++_i) \
        __builtin_amdgcn_global_load_lds((const unsigned*)((const char*)(gbase) + (voff)[_i]), (PG8_LAS unsigned*)(lds + (bufoff) + ldsw + _i * 8192), 16, 0, 0); } while (0)
#define PG8_LDA(dst, b, h) do { _Pragma("unroll") for (int m = 0; m < 4; ++m) _Pragma("unroll") for (int k = 0; k < 2; ++k) dst[m][k] = *(const PG8_LAS bf16x8*)(lds + PG8_SA(b, h) + aoff + m * 2048 + k * 1024); } while (0)
#define PG8_LDB(dst, b, h) do { _Pragma("unroll") for (int n = 0; n < 2; ++n) _Pragma("unroll") for (int k = 0; k < 2; ++k) dst[n][k] = *(const PG8_LAS bf16x8*)(lds + PG8_SB(b, h) + boff + n * 2048 + k * 1024); } while (0)
#define PG8_MMA(ai, bj, At, Bt) do { __builtin_amdgcn_s_setprio(1); _Pragma("unroll") for (int m = 0; m < 4; ++m) _Pragma("unroll") for (int n = 0; n < 2; ++n) _Pragma("unroll") for (int k = 0; k < 2; ++k) \
        acc[ai][bj][m][n] = __builtin_amdgcn_mfma_f32_16x16x32_bf16(Bt[n][k], At[m][k], acc[ai][bj][m][n], 0, 0, 0); __builtin_amdgcn_s_setprio(0); } while (0)
#define PG8_WAIT_V(n) asm volatile("s_waitcnt vmcnt(" #n ")" ::: "memory")
#define PG8_WAIT_L(n) asm volatile("s_waitcnt lgkmcnt(" #n ")" ::: "memory")
#define PG8_BAR __builtin_amdgcn_s_barrier()
#define PG8_SCHED __builtin_amdgcn_sched_barrier(0)
    Unit cur, nxt; int ui = 0;
    if (!S.next(0, cur)) return;
    f32x4 acc[2][2][4][2];
#pragma unroll
    for (int a = 0; a < 2; ++a)
#pragma unroll
        for (int b = 0; b < 2; ++b)
#pragma unroll
            for (int m = 0; m < 4; ++m)
#pragma unroll
                for (int n = 0; n < 2; ++n) acc[a][b][m][n] = (f32x4){0.f, 0.f, 0.f, 0.f};
    bf16x8 At[4][2], B0[2][2], B1[2][2];
    const char* cA = (const char*)g.A + (size_t)cur.pm * tstep; const char* cB = (const char*)g.Bt + (size_t)cur.pn * tstep;
    S.a_ready(cur);
    if constexpr (SP2) {
        PG8_STAGE(PG8_SB(0, 0), cB, voffB); PG8_STAGE(PG8_SB(0, 1), cB + hstep, voffB); PG8_STAGE(PG8_SA(0, 0), cA, voffA); PG8_STAGE(PG8_SA(0, 1), cA + hstep, voffA);
        if (wr == 1) PG8_BAR;
        PG8_WAIT_V(2); PG8_BAR;
        PG8_STAGE(PG8_SB(1, 0), cB + kstep, voffB); PG8_STAGE(PG8_SA(1, 0), cA + kstep, voffA); PG8_STAGE(PG8_SB(1, 1), cB + hstep + kstep, voffB);
        PG8_WAIT_V(6); PG8_BAR;
    } else {
        PG8_STAGE(PG8_SB(0, 0), cB, voffB); PG8_STAGE(PG8_SA(0, 0), cA, voffA); PG8_STAGE(PG8_SB(0, 1), cB + hstep, voffB); PG8_STAGE(PG8_SA(0, 1), cA + hstep, voffA);
        if (wr == 1) PG8_BAR;
        PG8_WAIT_V(4); PG8_BAR;
        PG8_STAGE(PG8_SB(1, 0), cB + kstep, voffB); PG8_STAGE(PG8_SA(1, 0), cA + kstep, voffA); PG8_STAGE(PG8_SB(1, 1), cB + hstep + kstep, voffB);
        PG8_WAIT_V(6); PG8_BAR;
    }
    for (;;) {
        const bool has_next = S.next(ui + 1, nxt);
        const char* nA = has_next ? (const char*)g.A + (size_t)nxt.pm * tstep : cA; const char* nB = has_next ? (const char*)g.Bt + (size_t)nxt.pn * tstep : cB;
        for (int t = 0; t < nt; t += 2) {
            const bool last = (t == nt - 2);
            const char* a1 = cA + (size_t)(t + 1) * kstep;
            const char* a2 = last ? nA : cA + (size_t)(t + 2) * kstep; const char* b2 = last ? nB : cB + (size_t)(t + 2) * kstep;
            const char* a3 = a2 + kstep; const char* b3 = b2 + kstep;
            if (last && has_next) S.a_ready(nxt);
            if constexpr (SP2) {
            PG8_LDB(B0, 0, 0); PG8_LDB(B1, 0, 1); PG8_SCHED; PG8_LDA(At, 0, 0); PG8_STAGE(PG8_SA(1, 1), a1 + hstep, voffA);
            PG8_WAIT_V(8); PG8_WAIT_L(0); PG8_BAR; PG8_MMA(0, 0, At, B0); PG8_MMA(0, 1, At, B1); PG8_BAR; PG8_SCHED;
            PG8_LDA(At, 0, 1); PG8_STAGE(PG8_SB(0, 0), b2, voffB); PG8_STAGE(PG8_SB(0, 1), b2 + hstep, voffB); PG8_STAGE(PG8_SA(0, 0), a2, voffA);
            PG8_WAIT_V(8); PG8_WAIT_L(0); PG8_BAR; PG8_MMA(1, 0, At, B0); PG8_MMA(1, 1, At, B1); PG8_BAR; PG8_SCHED;
            PG8_LDB(B0, 1, 0); PG8_LDB(B1, 1, 1); PG8_SCHED; PG8_LDA(At, 1, 0); PG8_STAGE(PG8_SA(0, 1), a2 + hstep, voffA);
            PG8_WAIT_V(8); PG8_WAIT_L(0); PG8_BAR; PG8_MMA(0, 0, At, B0); PG8_MMA(0, 1, At, B1); PG8_BAR; PG8_SCHED;
            PG8_LDA(At, 1, 1); PG8_STAGE(PG8_SB(1, 0), b3, voffB); PG8_STAGE(PG8_SB(1, 1), b3 + hstep, voffB); PG8_STAGE(PG8_SA(1, 0), a3, voffA);
            PG8_WAIT_V(8); PG8_WAIT_L(0); PG8_BAR; PG8_MMA(1, 0, At, B0); PG8_MMA(1, 1, At, B1); PG8_BAR; PG8_SCHED;
            } else {
            PG8_LDB(B0, 0, 0); PG8_SCHED; PG8_LDA(At, 0, 0); PG8_STAGE(PG8_SA(1, 1), a1 + hstep, voffA);
            PG8_WAIT_L(8); PG8_BAR; PG8_WAIT_L(0); PG8_MMA(0, 0, At, B0); PG8_BAR; PG8_SCHED;
            PG8_LDB(B1, 0, 1); PG8_STAGE(PG8_SB(0, 0), b2, voffB);
            PG8_BAR; PG8_WAIT_L(0); PG8_MMA(0, 1, At, B1); PG8_BAR;
            PG8_LDA(At, 0, 1); PG8_STAGE(PG8_SA(0, 0), a2, voffA);
            PG8_BAR; PG8_WAIT_L(0); PG8_MMA(1, 0, At, B0); PG8_BAR; PG8_SCHED;
            PG8_STAGE(PG8_SB(0, 1), b2 + hstep, voffB);
            PG8_WAIT_V(6); PG8_BAR; PG8_MMA(1, 1, At, B1); PG8_BAR;
            PG8_LDB(B0, 1, 0); PG8_SCHED; PG8_LDA(At, 1, 0); PG8_STAGE(PG8_SA(0, 1), a2 + hstep, voffA);
            PG8_WAIT_L(8); PG8_BAR; PG8_WAIT_L(0); PG8_MMA(0, 0, At, B0); PG8_BAR; PG8_SCHED;
            PG8_LDB(B1, 1, 1); PG8_STAGE(PG8_SB(1, 0), b3, voffB);
            PG8_BAR; PG8_WAIT_L(0); PG8_MMA(0, 1, At, B1); PG8_BAR;
            PG8_LDA(At, 1, 1); PG8_STAGE(PG8_SA(1, 0), a3, voffA);
            PG8_BAR; PG8_WAIT_L(0); PG8_MMA(1, 0, At, B0); PG8_BAR; PG8_SCHED;
            PG8_STAGE(PG8_SB(1, 1), b3 + hstep, voffB);
            PG8_WAIT_V(6); PG8_BAR; PG8_MMA(1, 1, At, B1); PG8_BAR;
            }
        }
        if constexpr (ALIGN_EPI) { if (wr == 0) PG8_BAR; }
        bool keep = false;
        if constexpr (Epi::CHAIN) keep = E.mid(acc, cur, wr, wc, fr, fq);
        if (!keep) { if constexpr (!Epi::AFTER_DRAIN) { E(acc, cur, wr, wc, fr, fq); S.done(cur); } }
        if (!has_next) break;
        if (!keep)
#pragma unroll
        for (int a = 0; a < 2; ++a)
#pragma unroll
            for (int b = 0; b < 2; ++b)
#pragma unroll
                for (int m = 0; m < 4; ++m)
#pragma unroll
                    for (int n = 0; n < 2; ++n) acc[a][b][m][n] = (f32x4){0.f, 0.f, 0.f, 0.f};
        cur = nxt; cA = nA; cB = nB; ++ui;
        if constexpr (ALIGN_EPI) { if (wr == 1) PG8_BAR; }
    }
    PG8_WAIT_V(0);
    if constexpr (!ALIGN_EPI) { if (wr == 0) PG8_BAR; }
    PG8_BAR;
    if constexpr (Epi::AFTER_DRAIN) { E.fused(acc, cur, wr, wc, fr, fq, lds, wid, lane); S.done(cur); }
#undef PG8_SA
#undef PG8_SB
#undef PG8_STAGE
#undef PG8_LDA
#undef PG8_LDB
#undef PG8_MMA
#undef PG8_WAIT_V
#undef PG8_WAIT_L
#undef PG8_BAR
#undef PG8_SCHED
}
}

constexpr int T_ = 8192, M_ = 16384, DM = 1024, NLAYER = 2;
constexpr int UA_LD = 2816, UB_LD = 1280;
constexpr size_t MiB = 1u << 20;
constexpr size_t WS_SSQ = 0, WS_DL = 1 * MiB, WS_BAR = 20 * MiB + 768 * 1024, WS_WIN = 2 * MiB, WS_WPA = 14 * MiB, WS_WPB = 15 * MiB, WS_WOUT = 16 * MiB, WS_WGATE = 18 * MiB,
                 WS_WPLE = 20 * MiB, WS_UPT = 20 * MiB + 512 * 1024, WS_XB = 21 * MiB, WS_VF = 53 * MiB, WS_OB = 69 * MiB, WS_OA = 85 * MiB, WS_UA = 101 * MiB,
                 WS_SC = 189 * MiB, WS_UB = 189 * MiB, WS_GATES = 101 * MiB, WS_P16 = 165 * MiB, WS_MERGED = 189 * MiB, WS_PLE = 221 * MiB, WS_END = 253 * MiB;
constexpr size_t SC_AH = 0, SC_BT = 16 * MiB, SC_U0 = 32 * MiB, SC_VK = 48 * MiB;
constexpr int LDS_BYTES = 147456;

struct KArgs { const float* in[26]; float* out; unsigned char* ws; };
constexpr int PARAMS_OFF = LDS_BYTES - 256;
struct Params {
    const unsigned char* sm;
    DI unsigned long long ld(int i) const { unsigned a = (unsigned)(PARAMS_OFF + i * 8); asm volatile("" : "+v"(a)); const unsigned long long v = *(const unsigned long long*)(sm + a);
        const unsigned lo = __builtin_amdgcn_readfirstlane((unsigned)v), hi = __builtin_amdgcn_readfirstlane((unsigned)(v >> 32)); return ((unsigned long long)hi << 32) | lo; }
    DI const float* in(int i) const { return (const float*)(__attribute__((address_space(1))) const float*)ld(i); }
    DI float* out() const { return (float*)(__attribute__((address_space(1))) float*)ld(26); }
    DI unsigned char* scb(int b) const { return b ? (unsigned char*)out() : ws() + WS_SC; }
    DI unsigned char* ws() const { return (unsigned char*)(__attribute__((address_space(1))) unsigned char*)ld(27); }
};
enum { I_X = 0, I_P, I_NORMG, I_WIN, I_MU, I_W0, I_DUP, I_A0, I_IUP, I_VD, I_VU, I_V0, I_KK, I_KA, I_RK, I_LNW, I_LNB, I_QG, I_KG, I_SINK, I_PA, I_PB, I_WOUT, I_PLEG, I_PLEW, I_PLEP };

typedef float f32x2_t __attribute__((ext_vector_type(2)));
typedef __bf16 bf16x2_t __attribute__((ext_vector_type(2)));
DI unsigned pk2(float lo, float hi) { const f32x2_t v = {lo, hi}; const bf16x2_t b = __builtin_convertvector(v, bf16x2_t); return __builtin_bit_cast(unsigned, b); }
DI unsigned short f2bf(float f) { return (unsigned short)(pk2(f, 0.f) & 0xffffu); }
DI float bf2f(unsigned short h) { return __uint_as_float(((unsigned)h) << 16); }
DI float bflo(unsigned w) { return __uint_as_float(w << 16); }
DI float bfhi(unsigned w) { return __uint_as_float(w & 0xffff0000u); }
DI float sigm(float x) { return __builtin_amdgcn_rcpf(1.f + __expf(-x)); }
DI void wave_sum8(float (&v)[8]) {
    const int lane = __lane_id();
    const bool h32 = lane & 32, h16 = lane & 16, h8 = lane & 8;
    float a[4], b2[2], c1;
#pragma unroll
    for (int i = 0; i < 4; ++i) { const float send = h32 ? v[i] : v[4 + i], keep = h32 ? v[4 + i] : v[i]; a[i] = keep + __shfl_xor(send, 32); }
#pragma unroll
    for (int i = 0; i < 2; ++i) { const float send = h16 ? a[i] : a[2 + i], keep = h16 ? a[2 + i] : a[i]; b2[i] = keep + __shfl_xor(send, 16); }
    { const float send = h8 ? b2[0] : b2[1], keep = h8 ? b2[1] : b2[0]; c1 = keep + __shfl_xor(send, 8); }
    c1 += __shfl_xor(c1, 4); c1 += __shfl_xor(c1, 2); c1 += __shfl_xor(c1, 1);
#pragma unroll
    for (int e = 0; e < 8; ++e) v[e] = __int_as_float(__builtin_amdgcn_readlane(__float_as_int(c1), ((e >> 2) & 1) * 32 + ((e >> 1) & 1) * 16 + (e & 1) * 8));
}
DI float wave_sum(float v) {
#pragma unroll
    for (int o = 32; o; o >>= 1) v += __shfl_xor(v, o);
    return v;
}
#define MFMA16(a, b, c) __builtin_amdgcn_mfma_f32_16x16x32_bf16((a), (b), (c), 0, 0, 0)

enum { EP_U = 0, EP_GATE, EP_PA, EP_PB, EP_PLE, EP_OUT, EP_FIN, EP_PAB };
template <int MODE> struct Epi {
    static constexpr bool PERM = true, AFTER_DRAIN = false, CHAIN = (MODE == EP_PAB);
    const float* ssq;
    bf16_t* o0; bf16_t* o1;
    const bf16_t* g;
    const float* xres; float* xout; float* ssq_out;
    DI bool mid(f32x4 (&acc)[2][2][4][2], const pg8::Unit& u, int wr, int wc, int fr, int fq) const {
        if (u.pn >= 4) return false;
        const int row0 = (u.pm - 64) * 256 + wr * 64 + fr, colb = u.pn * 256 + wc * 32 + 8 * fq;
#pragma unroll
        for (int ai = 0; ai < 2; ++ai)
#pragma unroll
            for (int m = 0; m < 4; ++m)
#pragma unroll
                for (int bj = 0; bj < 2; ++bj) {
                    const size_t o = (size_t)(row0 + ai * 128 + m * 16) * 2048 + colb + bj * 128;
                    const u32x4 ga = *(const u32x4*)(g + o), gb = *(const u32x4*)(g + o + 1024);
                    const float ra[8] = {bflo(ga.x), bfhi(ga.x), bflo(ga.y), bfhi(ga.y), bflo(ga.z), bfhi(ga.z), bflo(ga.w), bfhi(ga.w)};
                    const float rb[8] = {bflo(gb.x), bfhi(gb.x), bflo(gb.y), bfhi(gb.y), bflo(gb.z), bfhi(gb.z), bflo(gb.w), bfhi(gb.w)};
#pragma unroll
                    for (int e = 0; e < 4; ++e) { acc[ai][bj][m][0][e] *= ra[e] * __builtin_amdgcn_rcpf(rb[e]); acc[ai][bj][m][1][e] *= ra[4 + e] * __builtin_amdgcn_rcpf(rb[4 + e]); }
                }
        return true;
    }
    DI void operator()(const f32x4 (&acc)[2][2][4][2], const pg8::Unit& u0, int wr, int wc, int fr, int fq) const {
        pg8::Unit u = u0; if (MODE == EP_PAB) u.pn -= 4;
        const int row0 = u.pm * 256 + wr * 64 + fr, colb = u.pn * 256 + wc * 32 + 8 * fq;
#pragma unroll
        for (int ai = 0; ai < 2; ++ai)
#pragma unroll
            for (int m = 0; m < 4; ++m) {
                const int row = row0 + ai * 128 + m * 16;
                float rs = 1.f;
                if (MODE == EP_U || MODE == EP_GATE) rs = rsqrtf(ssq[(size_t)row * 16] * (1.0f / 1024.0f) + 1e-6f);
                if (MODE == EP_FIN) {
                    const f32x4* sp = (const f32x4*)(ssq + (size_t)row * 16);
                    f32x4 a = sp[0], b = sp[1], c = sp[2], d = sp[3];
                    float s = ((a[0] + a[1]) + (a[2] + a[3])) + ((b[0] + b[1]) + (b[2] + b[3])) + ((c[0] + c[1]) + (c[2] + c[3])) + ((d[0] + d[1]) + (d[2] + d[3]));
                    rs = rsqrtf(s * (1.0f / 1024.0f) + 1e-6f);
                }
                float sq = 0.f;
#pragma unroll
                for (int bj = 0; bj < 2; ++bj) {
                    const int col = colb + bj * 128;
                    float v[8];
#pragma unroll
                    for (int e = 0; e < 4; ++e) { v[e] = acc[ai][bj][m][0][e] * rs; v[4 + e] = acc[ai][bj][m][1][e] * rs; }
                    if (MODE == EP_U) {
                        bf16_t* dst;
                        if (u.pn < 9) dst = o0 + (size_t)row * UA_LD + col;
                        else if (u.pn < 14) dst = o1 + (size_t)row * UB_LD + (col - 2304);
                        else dst = o0 + (size_t)row * UA_LD + 2304 + (col - 3584);
                        u32x4 w; w.x = pk2(v[0], v[1]); w.y = pk2(v[2], v[3]); w.z = pk2(v[4], v[5]); w.w = pk2(v[6], v[7]);
                        *(u32x4*)dst = w;
                    } else if (MODE == EP_GATE) {
                        u32x4 w; w.x = pk2(sigm(v[0]), sigm(v[1])); w.y = pk2(sigm(v[2]), sigm(v[3])); w.z = pk2(sigm(v[4]), sigm(v[5])); w.w = pk2(sigm(v[6]), sigm(v[7]));
                        *(u32x4*)(o0 + (size_t)row * 2048 + col) = w;
                    } else if (MODE == EP_PA || MODE == EP_PB) {
                        const u32x4 gw = *(const u32x4*)(g + (size_t)row * 2048 + (MODE == EP_PB ? 1024 : 0) + col);
                        float gg[8] = {bflo(gw.x), bfhi(gw.x), bflo(gw.y), bfhi(gw.y), bflo(gw.z), bfhi(gw.z), bflo(gw.w), bfhi(gw.w)};
                        bf16_t* dst = o0 + (size_t)row * 1024 + col;
                        float o[8];
                        if (MODE == EP_PB) { const u32x4 ow = *(const u32x4*)dst; o[0] = bflo(ow.x); o[1] = bfhi(ow.x); o[2] = bflo(ow.y); o[3] = bfhi(ow.y); o[4] = bflo(ow.z); o[5] = bfhi(ow.z); o[6] = bflo(ow.w); o[7] = bfhi(ow.w); }
                        else { for (int e = 0; e < 8; ++e) o[e] = 0.f; }
#pragma unroll
                        for (int e = 0; e < 8; ++e) o[e] += gg[e] * v[e];
                        u32x4 w; w.x = pk2(o[0], o[1]); w.y = pk2(o[2], o[3]); w.z = pk2(o[4], o[5]); w.w = pk2(o[6], o[7]);
                        *(u32x4*)dst = w;
                    } else if (MODE == EP_PAB) {
                        const u32x4 gw = *(const u32x4*)(g + (size_t)row * 2048 + 1024 + col);
                        const float gg[8] = {bflo(gw.x), bfhi(gw.x), bflo(gw.y), bfhi(gw.y), bflo(gw.z), bfhi(gw.z), bflo(gw.w), bfhi(gw.w)};
                        u32x4 w; w.x = pk2(gg[0] * v[0], gg[1] * v[1]); w.y = pk2(gg[2] * v[2], gg[3] * v[3]); w.z = pk2(gg[4] * v[4], gg[5] * v[5]); w.w = pk2(gg[6] * v[6], gg[7] * v[7]);
                        *(u32x4*)(o0 + (size_t)row * 1024 + col) = w;
                    } else if (MODE == EP_PLE) {
                        u32x4 w; w.x = pk2(v[0], v[1]); w.y = pk2(v[2], v[3]); w.z = pk2(v[4], v[5]); w.w = pk2(v[6], v[7]);
                        *(u32x4*)(o0 + (size_t)row * 1024 + col) = w;
                    } else if (MODE == EP_OUT) {
                        float o[8];
                        if (xres) {
                            const f32x4 x0 = *(const f32x4*)(xres + (size_t)row * 1024 + col), x1 = *(const f32x4*)(xres + (size_t)row * 1024 + col + 4);
#pragma unroll
                            for (int e = 0; e < 4; ++e) { o[e] = x0[e] + v[e]; o[4 + e] = x1[e] + v[4 + e]; }
                        } else {
                            const u32x4 xw = *(const u32x4*)(o0 + (size_t)row * 1024 + col);
                            o[0] = bflo(xw.x) + v[0]; o[1] = bfhi(xw.x) + v[1]; o[2] = bflo(xw.y) + v[2]; o[3] = bfhi(xw.y) + v[3];
                            o[4] = bflo(xw.z) + v[4]; o[5] = bfhi(xw.z) + v[5]; o[6] = bflo(xw.w) + v[6]; o[7] = bfhi(xw.w) + v[7];
                        }
#pragma unroll
                        for (int e = 0; e < 8; ++e) sq += o[e] * o[e];
                        u32x4 w; w.x = pk2(o[0], o[1]); w.y = pk2(o[2], o[3]); w.z = pk2(o[4], o[5]); w.w = pk2(o[6], o[7]);
                        *(u32x4*)(o0 + (size_t)row * 1024 + col) = w;
                    } else if (MODE == EP_FIN) {
                        const u32x4 xw = *(const u32x4*)(o0 + (size_t)row * 1024 + col);
                        const f32x4 x0 = (f32x4){bflo(xw.x), bfhi(xw.x), bflo(xw.y), bfhi(xw.y)}, x1 = (f32x4){bflo(xw.z), bfhi(xw.z), bflo(xw.w), bfhi(xw.w)};
                        const u32x4 pw = *(const u32x4*)(g + (size_t)row * 1024 + col);
                        float pp[8] = {bflo(pw.x), bfhi(pw.x), bflo(pw.y), bfhi(pw.y), bflo(pw.z), bfhi(pw.z), bflo(pw.w), bfhi(pw.w)};
                        float o[8];
#pragma unroll
                        for (int e = 0; e < 4; ++e) { o[e] = x0[e] + sigm(v[e]) * pp[e]; o[4 + e] = x1[e] + sigm(v[4 + e]) * pp[4 + e]; }
                        if (ssq_out) {
#pragma unroll
                            for (int e = 0; e < 8; ++e) sq += o[e] * o[e];
                            u32x4 w; w.x = pk2(o[0], o[1]); w.y = pk2(o[2], o[3]); w.z = pk2(o[4], o[5]); w.w = pk2(o[6], o[7]);
                            *(u32x4*)(o1 + (size_t)row * 1024 + col) = w;
                        } else {
                            *(f32x4*)(xout + (size_t)row * 1024 + col) = (f32x4){o[0], o[1], o[2], o[3]};
                            *(f32x4*)(xout + (size_t)row * 1024 + col + 4) = (f32x4){o[4], o[5], o[6], o[7]};
                        }
                    }
                }
                if (MODE == EP_OUT || (MODE == EP_FIN && ssq_out)) {
                    sq += __shfl_xor(sq, 16); sq += __shfl_xor(sq, 32);
                    if (fq == 0) ssq_out[(size_t)row * 16 + u.pn * 4 + wc] = sq;
                }
            }
    }
};

struct PairOrder {
    pg8::StaticOrder so;
    DI void init(int G, int c) { so.init(M_, 1024, G, c); }
    DI bool next(int i, pg8::Unit& u) const { pg8::Unit t; if (!so.next(i >> 1, t)) return false; if (i & 1) { u.pm = t.pm; u.pn = t.pn + 4; } else { u.pm = t.pm + 64; u.pn = t.pn; } return true; }
    DI void a_ready(const pg8::Unit&) const {}
    DI void done(const pg8::Unit&) const {}
};
DI void run_gemm_pair(unsigned char* smem, const bf16_t* Astk, const bf16_t* Bstk, const Epi<EP_PAB>& E) {
    int N = 2048, K = 512;
    asm volatile("" : "+s"(N), "+s"(K));
    pg8::Gemm g{Astk, Bstk, 2 * M_, N, K}; PairOrder S; S.init((int)gridDim.x, obid());
    pg8::gemm_phase<Epi<EP_PAB>, PairOrder, true, true>((PG8_LAS unsigned char*)smem, g, S, E);
    __syncthreads();
}
template <int MODE> DI void run_gemm(unsigned char* smem, const bf16_t* A, const bf16_t* Bt, int N, int K, const Epi<MODE>& E) {
    asm volatile("" : "+s"(N), "+s"(K));
    pg8::Gemm g{A, Bt, M_, N, K}; pg8::StaticOrder S; S.init(M_, N, (int)gridDim.x, (int)obid());
    pg8::gemm_phase<Epi<MODE>, pg8::StaticOrder, true, true>((PG8_LAS unsigned char*)smem, g, S, E);
    __syncthreads();
}

DI void transpose_job(const float* src, int lds_, const float* g, bf16_t* dst, int ldd, int K, int N, float* sm, int& rot) {
    const int tid = otid(), nk = K >> 6, nn = N >> 8, nt = nk * nn, G = gridDim.x;
    int first = obid() - rot; if (first < 0) first += G;
    rot = (rot + nt) % G;
    for (int t = first; t < nt; t += G) {
        const int k0 = (t % nk) << 6, n0 = (t / nk) << 8;
        f32x4 v8[8]; float g8[8];
#pragma unroll
        for (int i = 0; i < 8; ++i) {
            const int idx = tid + 512 * i, k = idx >> 6, n4 = (idx & 63) * 4;
            v8[i] = *(const f32x4*)(src + (size_t)(k0 + k) * lds_ + n0 + n4);
            g8[i] = g ? g[k0 + k] : 1.f;
        }
#pragma unroll
        for (int i = 0; i < 8; ++i) {
            const int idx = tid + 512 * i, k = idx >> 6, n4 = (idx & 63) * 4;
            const f32x4 v = v8[i] * g8[i];
            float* o = sm + k * 257 + n4; o[0] = v[0]; o[1] = v[1]; o[2] = v[2]; o[3] = v[3];
        }
        __syncthreads();
#pragma unroll
        for (int i = 0; i < 4; ++i) {
            const int idx = tid + 512 * i, n = idx >> 3, kc = (idx & 7) * 8;
            const float* p = sm + kc * 257 + n;
            u32x4 w; w.x = pk2(p[0], p[257]); w.y = pk2(p[2 * 257], p[3 * 257]); w.z = pk2(p[4 * 257], p[5 * 257]); w.w = pk2(p[6 * 257], p[7 * 257]);
            *(u32x4*)(dst + (size_t)(n0 + n) * ldd + k0 + kc) = w;
        }
        __syncthreads();
    }
}
DI void p0_phase(const Params& P, int l, unsigned char* smem, const float* xsrc, int part) {
    unsigned char* ws = P.ws(); float* sm = (float*)smem; int rot = 0;
    const float* ng = P.in(I_NORMG) + l * 1024;
    const float* win = P.in(I_WIN) + (size_t)l * 1024 * 5632;
    bf16_t* WIN = (bf16_t*)(ws + WS_WIN);
    if (part & 2) transpose_job(P.in(I_PLEW) + (size_t)l * 1024 * 1024, 1024, P.in(I_PLEG) + l * 1024, (bf16_t*)(ws + WS_WGATE), 1024, 1024, 1024, sm, rot);
    if (part & 1) {
    transpose_job(win, 5632, ng, WIN, 1024, 1024, 3584, sm, rot);
    transpose_job(win + 3584, 5632, ng, WIN + (size_t)4096 * 1024, 1024, 1024, 2048, sm, rot);
    transpose_job(P.in(I_PA) + (size_t)l * 512 * 1024, 1024, nullptr, (bf16_t*)(ws + WS_WPA), 512, 512, 1024, sm, rot);
    transpose_job(P.in(I_PB) + (size_t)l * 512 * 1024, 1024, nullptr, (bf16_t*)(ws + WS_WPB), 512, 512, 1024, sm, rot);
    transpose_job(P.in(I_WOUT) + (size_t)l * 1024 * 1024, 1024, nullptr, (bf16_t*)(ws + WS_WOUT), 1024, 1024, 1024, sm, rot);
    transpose_job(P.in(I_PLEP) + (size_t)l * 256 * 1024, 1024, nullptr, (bf16_t*)(ws + WS_WPLE), 256, 256, 1024, sm, rot);
    for (int d = 0; d < 2; ++d) {
        transpose_job(P.in(I_DUP) + (size_t)(l * 2 + d) * 64 * 512, 512, nullptr, (bf16_t*)(ws + WS_UPT) + (size_t)d * 512 * 64, 64, 64, 512, sm, rot);
        transpose_job(P.in(I_IUP) + (size_t)(l * 2 + d) * 64 * 512, 512, nullptr, (bf16_t*)(ws + WS_UPT) + (size_t)(2 + d) * 512 * 64, 64, 64, 512, sm, rot);
    }
    if (l > 0) {
        const float* vd = P.in(I_VD) + (size_t)(l - 1) * 1024 * 32; const float* vu = P.in(I_VU) + (size_t)(l - 1) * 32 * 512;
        for (int idx = obid() * 512 + otid(); idx < 512 * 1024; idx += gridDim.x * 512) {
            const int n = idx >> 10, k = idx & 1023; float s = 0.f;
#pragma unroll 8
            for (int r = 0; r < 32; ++r) s += vd[k * 32 + r] * vu[r * 512 + n];
            WIN[(size_t)(3584 + n) * 1024 + k] = f2bf(s * ng[k]);
        }
    }
    }
    if (!(part & 2)) return;
    if (l > 0) {
        const int wave = otid() >> 6, lane = otid() & 63;
        bf16_t* XB = (bf16_t*)(ws + WS_XB); float* ssq = (float*)(ws + WS_SSQ); const float* sq2 = (const float*)(ws + WS_DL); const bf16_t* xb16 = (const bf16_t*)xsrc;
        for (int row0 = (obid() * 8 + wave) * 4; row0 < M_; row0 += gridDim.x * 32) {
            u32x4 v[4][2]; float pr[4];
#pragma unroll
            for (int i = 0; i < 4; ++i) { v[i][0] = *(const u32x4*)(xb16 + (size_t)(row0 + i) * 1024 + lane * 8); v[i][1] = *(const u32x4*)(xb16 + (size_t)(row0 + i) * 1024 + 512 + lane * 8);
                                          pr[i] = sq2[(size_t)(row0 + i) * 16 + (lane & 15)]; }
#pragma unroll
            for (int i = 0; i < 4; ++i) {
                *(u32x4*)(XB + (size_t)(row0 + i) * 1024 + lane * 8) = v[i][0]; *(u32x4*)(XB + (size_t)(row0 + i) * 1024 + 512 + lane * 8) = v[i][1];
                float t = lane < 16 ? pr[i] : 0.f; t = wave_sum(t);
                if (lane < 16) ssq[(size_t)(row0 + i) * 16 + lane] = (lane == 0) ? t : 0.f;
            }
        }
    } else
    {
        const int wave = otid() >> 6, lane = otid() & 63;
        bf16_t* XB = (bf16_t*)(ws + WS_XB); float* ssq = (float*)(ws + WS_SSQ);
        for (int row0 = (obid() * 8 + wave) * 4; row0 < M_; row0 += gridDim.x * 32) {
            f32x4 v[4][4];
#pragma unroll
            for (int i = 0; i < 4; ++i)
#pragma unroll
                for (int j = 0; j < 4; ++j) v[i][j] = *(const f32x4*)(xsrc + (size_t)(row0 + i) * 1024 + j * 256 + lane * 4);
#pragma unroll
            for (int i = 0; i < 4; ++i) {
                float s = 0.f;
#pragma unroll
                for (int j = 0; j < 4; ++j) {
                    const f32x4 x = v[i][j];
                    s += x[0] * x[0] + x[1] * x[1] + x[2] * x[2] + x[3] * x[3];
                    u32x2 w; w.x = pk2(x[0], x[1]); w.y = pk2(x[2], x[3]);
                    *(u32x2*)(XB + (size_t)(row0 + i) * 1024 + j * 256 + lane * 4) = w;
                }
                s = wave_sum(s);
                if (lane < 16) ssq[(size_t)(row0 + i) * 16 + lane] = (lane == 0) ? s : 0.f;
            }
        }
    }
}
DI void p16_phase(const Params& P, int l) {
    const float* src = P.in(I_P) + (size_t)l * M_ * 256; bf16_t* dst = (bf16_t*)(P.ws() + WS_P16);
    const unsigned n4 = (unsigned)(M_ * 256 / 4), stride = gridDim.x * 512u;
    for (unsigned i = (unsigned)obid() * 512u + (unsigned)otid(); i < n4; i += stride * 8u) {
        f32x4 v[8];
#pragma unroll
        for (int k = 0; k < 8; ++k) { const unsigned j = i + (unsigned)k * stride; v[k] = *(const f32x4*)(src + (size_t)(j < n4 ? j : n4 - 1u) * 4); }
#pragma unroll
        for (int k = 0; k < 8; ++k) { const unsigned j = i + (unsigned)k * stride; if (j < n4) { u32x2 w; w.x = pk2(v[k][0], v[k][1]); w.y = pk2(v[k][2], v[k][3]); *(u32x2*)(dst + (size_t)j * 4) = w; } }
    }
}

constexpr int AK_LD = 72, AV_LD = 456;
DI void attn_phase(const Params& P, int l, unsigned char* smem) {
    const bf16_t* UB = (const bf16_t*)(P.ws() + WS_UB); bf16_t* OB = (bf16_t*)(P.ws() + WS_OB);
    bf16_t* Ks = (bf16_t*)smem;
    bf16_t* Vt = (bf16_t*)(smem + 448 * AK_LD * 2);
    const int tid = otid(), lane = tid & 63, w = tid >> 6, r = lane & 15, q = lane >> 4;
    const float* qg = P.in(I_QG) + l * 64; const float* kg = P.in(I_KG) + l * 64;
    const float LOG2E = 1.4426950408889634f;
    for (int unit = obid(); unit < 256; unit += gridDim.x) {
        const int b = unit >> 7, g = (unit >> 6) & 1, qb = unit & 63;
        const int t0 = qb * 128, kstart = t0 - 128;
        const bf16_t* ub = UB + (size_t)b * T_ * UB_LD;
        __syncthreads();
        {
            const int seg = tid & 7;
            float kgl[8];
#pragma unroll
            for (int e = 0; e < 8; ++e) kgl[e] = kg[seg * 8 + e];
            for (int it = 0; it < 7; ++it) {
                const int key = (tid >> 3) + 64 * it, tok = kstart + key;
                u32x4 kw = (u32x4){0u, 0u, 0u, 0u}, vw = (u32x4){0u, 0u, 0u, 0u};
                { const bool ok = (key < 384 && tok >= 0 && tok < T_); const int tcl = tok < 0 ? 0 : (tok >= T_ ? T_ - 1 : tok);
                  const u32x4 k_ = *(const u32x4*)(ub + (size_t)tcl * UB_LD + 512 + g * 64 + seg * 8), v_ = *(const u32x4*)(ub + (size_t)tcl * UB_LD + 640 + g * 64 + seg * 8);
                  if (ok) { kw = k_; vw = v_; } }
                float kf[8] = {bflo(kw.x), bfhi(kw.x), bflo(kw.y), bfhi(kw.y), bflo(kw.z), bfhi(kw.z), bflo(kw.w), bfhi(kw.w)};
                float ss = 0.f;
#pragma unroll
                for (int e = 0; e < 8; ++e) ss += kf[e] * kf[e];
                ss += __shfl_xor(ss, 1); ss += __shfl_xor(ss, 2); ss += __shfl_xor(ss, 4);
                const float rs = rsqrtf(ss * (1.0f / 64.0f) + 1e-6f);
                u32x4 o; o.x = pk2(kf[0] * rs * kgl[0], kf[1] * rs * kgl[1]); o.y = pk2(kf[2] * rs * kgl[2], kf[3] * rs * kgl[3]);
                o.z = pk2(kf[4] * rs * kgl[4], kf[5] * rs * kgl[5]); o.w = pk2(kf[6] * rs * kgl[6], kf[7] * rs * kgl[7]);
                *(u32x4*)(Ks + key * AK_LD + seg * 8) = o;
                const unsigned vv[4] = {vw.x, vw.y, vw.z, vw.w};
#pragma unroll
                for (int e = 0; e < 4; ++e) { const int ks_ = key ^ (seg << 2);
                    Vt[(seg * 8 + 2 * e) * AV_LD + ks_] = (bf16_t)(vv[e] & 0xffffu); Vt[(seg * 8 + 2 * e + 1) * AV_LD + ks_] = (bf16_t)(vv[e] >> 16); }
            }
        }
        __syncthreads();
        const int hh = w >> 1, head = g * 4 + hh;
        const float slope2 = exp2f(-(float)(head + 1)) * LOG2E;
        const float sink2 = P.in(I_SINK)[l * 8 + head] * LOG2E;
#pragma unroll
        for (int qh = 0; qh < 2; ++qh) {
        const int qoff = (w & 1) * 64 + qh * 32, q0 = t0 + qoff;
        bf16x8 Qf[2][2];
#pragma unroll
        for (int qt = 0; qt < 2; ++qt) {
            const bf16_t* qp = ub + (size_t)(q0 + qt * 16 + r) * UB_LD + head * 64;
            float qv[16]; float ss = 0.f;
#pragma unroll
            for (int ks = 0; ks < 2; ++ks) {
                const u32x4 qw = *(const u32x4*)(qp + ks * 32 + q * 8);
                qv[ks * 8 + 0] = bflo(qw.x); qv[ks * 8 + 1] = bfhi(qw.x); qv[ks * 8 + 2] = bflo(qw.y); qv[ks * 8 + 3] = bfhi(qw.y);
                qv[ks * 8 + 4] = bflo(qw.z); qv[ks * 8 + 5] = bfhi(qw.z); qv[ks * 8 + 6] = bflo(qw.w); qv[ks * 8 + 7] = bfhi(qw.w);
            }
#pragma unroll
            for (int e = 0; e < 16; ++e) ss += qv[e] * qv[e];
            ss += __shfl_xor(ss, 16); ss += __shfl_xor(ss, 32);
            const float rs = rsqrtf(ss * (1.0f / 64.0f) + 1e-6f) * 0.125f * LOG2E;
#pragma unroll
            for (int ks = 0; ks < 2; ++ks) {
                u32x4 o;
                const float* gq = qg + ks * 32 + q * 8;
                o.x = pk2(qv[ks * 8 + 0] * rs * gq[0], qv[ks * 8 + 1] * rs * gq[1]); o.y = pk2(qv[ks * 8 + 2] * rs * gq[2], qv[ks * 8 + 3] * rs * gq[3]);
                o.z = pk2(qv[ks * 8 + 4] * rs * gq[4], qv[ks * 8 + 5] * rs * gq[5]); o.w = pk2(qv[ks * 8 + 6] * rs * gq[6], qv[ks * 8 + 7] * rs * gq[7]);
                Qf[qt][ks] = __builtin_bit_cast(bf16x8, o);
            }
        }
        f32x4 O[4][2];
        float mrun[2], lrun[2];
#pragma unroll
        for (int qt = 0; qt < 2; ++qt) { mrun[qt] = sink2; lrun[qt] = (q == 0) ? 1.f : 0.f;
#pragma unroll
            for (int dt = 0; dt < 4; ++dt) O[dt][qt] = (f32x4){0.f, 0.f, 0.f, 0.f}; }
        for (int kb = 0; kb < 5; ++kb) {
            const int kl0 = qoff + kb * 64;
            f32x4 S[4][2];
            {
                bf16x8 kf[4][2];
#pragma unroll
                for (int kt = 0; kt < 4; ++kt) { kf[kt][0] = *(const bf16x8*)(Ks + (kl0 + kt * 16 + r) * AK_LD + q * 8); kf[kt][1] = *(const bf16x8*)(Ks + (kl0 + kt * 16 + r) * AK_LD + 32 + q * 8); }
                __builtin_amdgcn_sched_barrier(0);
#pragma unroll
                for (int kt = 0; kt < 4; ++kt)
#pragma unroll
                    for (int qt = 0; qt < 2; ++qt) { f32x4 a = (f32x4){0.f, 0.f, 0.f, 0.f}; a = MFMA16(kf[kt][0], Qf[qt][0], a); a = MFMA16(kf[kt][1], Qf[qt][1], a); S[kt][qt] = a; }
            }
            bf16x8 vfr[2][4];
#pragma unroll
            for (int ps = 0; ps < 2; ++ps)
#pragma unroll
                for (int dt = 0; dt < 4; ++dt) {
                    const bf16_t* vp = Vt + (dt * 16 + r) * AV_LD + kl0 + ps * 32; const int gsw = ((2 * dt + (r >> 3)) & 7) << 2;
                    const u32x2 v0 = *(const u32x2*)(vp + ((4 * q) ^ gsw)), v1 = *(const u32x2*)(vp + ((4 * q + 16) ^ gsw));
                    u32x4 vv; vv.x = v0.x; vv.y = v0.y; vv.z = v1.x; vv.w = v1.y;
                    vfr[ps][dt] = __builtin_bit_cast(bf16x8, vv);
                }
            __builtin_amdgcn_sched_barrier(0);
#pragma unroll
            for (int qt = 0; qt < 2; ++qt) {
                const int qpos = q0 + qt * 16 + r;
                float mx = -3.0e38f;
#pragma unroll
                for (int kt = 0; kt < 4; ++kt)
#pragma unroll
                    for (int j = 0; j < 4; ++j) {
                        const int kpos = kstart + kl0 + kt * 16 + 4 * q + j; int dist = qpos - kpos; dist = dist < 0 ? -dist : dist;
                        const bool valid = (dist <= 128) && (kpos >= 0) && (kpos < T_);
                        const float s = valid ? (S[kt][qt][j] - slope2 * (float)dist) : -1.0e30f;
                        S[kt][qt][j] = s; mx = fmaxf(mx, s);
                    }
                mx = fmaxf(mx, __shfl_xor(mx, 16)); mx = fmaxf(mx, __shfl_xor(mx, 32));
                const float mn = fmaxf(mrun[qt], mx), alpha = __builtin_amdgcn_exp2f(mrun[qt] - mn);
                mrun[qt] = mn; float ps = 0.f;
#pragma unroll
                for (int kt = 0; kt < 4; ++kt)
#pragma unroll
                    for (int j = 0; j < 4; ++j) { const float p = __builtin_amdgcn_exp2f(S[kt][qt][j] - mn); S[kt][qt][j] = p; ps += p; }
                lrun[qt] = lrun[qt] * alpha + ps;
#pragma unroll
                for (int dt = 0; dt < 4; ++dt) O[dt][qt] = O[dt][qt] * alpha;
            }
#pragma unroll
            for (int ps = 0; ps < 2; ++ps) {
                bf16x8 Pf[2];
#pragma unroll
                for (int qt = 0; qt < 2; ++qt) {
                    u32x4 o; o.x = pk2(S[2 * ps][qt][0], S[2 * ps][qt][1]); o.y = pk2(S[2 * ps][qt][2], S[2 * ps][qt][3]);
                    o.z = pk2(S[2 * ps + 1][qt][0], S[2 * ps + 1][qt][1]); o.w = pk2(S[2 * ps + 1][qt][2], S[2 * ps + 1][qt][3]);
                    Pf[qt] = __builtin_bit_cast(bf16x8, o);
                }
#pragma unroll
                for (int dt = 0; dt < 4; ++dt)
#pragma unroll
                    for (int qt = 0; qt < 2; ++qt) O[dt][qt] = MFMA16(vfr[ps][dt], Pf[qt], O[dt][qt]);
            }
        }
#pragma unroll
        for (int qt = 0; qt < 2; ++qt) {
            float lt = lrun[qt]; lt += __shfl_xor(lt, 16); lt += __shfl_xor(lt, 32);
            const float inv = 1.f / lt;
            const size_t row = (size_t)b * T_ + q0 + qt * 16 + r;
#pragma unroll
            for (int dt = 0; dt < 4; ++dt) {
                const int col = head * 64 + dt * 16 + 4 * q;
                const u32x2 zw = *(const u32x2*)(UB + row * UB_LD + 768 + col);
                const float z[4] = {bflo(zw.x), bfhi(zw.x), bflo(zw.y), bfhi(zw.y)};
                float o[4];
#pragma unroll
                for (int j = 0; j < 4; ++j) o[j] = O[dt][qt][j] * inv * (z[j] * sigm(z[j]));
                u32x2 ow; ow.x = pk2(o[0], o[1]); ow.y = pk2(o[2], o[3]);
                *(u32x2*)(OB + row * 512 + col) = ow;
            }
        }
        }
    }
    __syncthreads();
}

constexpr int LP = 72;
constexpr int OFF_DD = 0, OFF_ID = 9216, OFF_WR = 18432, OFF_AR = 35072, OFF_R = 51712, OFF_A = 60928, OFF_B = 70144, OFF_K = 79360, OFF_AT = 88576, OFF_KT = 97792, OFF_VT = 107008,
              OFF_GS = 116224, OFF_YS = 118272;
constexpr int OFF_P = 0, OFF_PT = 9216, OFF_T = 18432, OFF_MAK = 27648;
struct FE { float r[8], k[8], v[8], z[8], kk[8]; };

DI float ldbf(const bf16_t* base, unsigned byteoff) { return bf2f(*(const bf16_t*)((const unsigned char*)base + byteoff)); }
DI void load_shift8(const bf16_t* base, int t0, int col, float mu, float (&out)[8]) {
    float u[10];
    const int tlo = t0 > 0 ? t0 - 1 : 0, thi = t0 + 8 < T_ ? t0 + 8 : T_ - 1;
    const unsigned o0 = ((unsigned)t0 * UA_LD + (unsigned)col) * 2u;
    u[0] = ldbf(base, ((unsigned)tlo * UA_LD + (unsigned)col) * 2u); u[9] = ldbf(base, ((unsigned)thi * UA_LD + (unsigned)col) * 2u);
#pragma unroll
    for (int e = 0; e < 8; ++e) u[e + 1] = ldbf(base, o0 + (unsigned)e * (UA_LD * 2u));
    u[0] = t0 > 0 ? u[0] : 0.f; u[9] = t0 + 8 < T_ ? u[9] : 0.f;
#pragma unroll
    for (int e = 0; e < 8; ++e) out[e] = u[e + 1] + mu * (0.5f * (u[e] + u[e + 2]) - u[e + 1]);
}
DI f32x4 mm_tile_gs(const bf16_t* A, int lda, const bf16_t* Bt, int mt, int nt, int r, int q, f32x4 acc) {
#pragma unroll
    for (int ks = 0; ks < 2; ++ks) {
        const int row = nt * 16 + r;
        const bf16x8 a = *(const bf16x8*)(A + (mt * 16 + r) * lda + ks * 32 + q * 8);
        const bf16x8 b = *(const bf16x8*)(Bt + row * 64 + (((4 * ks + q) ^ ((row >> 1) & 7)) * 8));
        acc = MFMA16(a, b, acc);
    }
    return acc;
}
DI f32x4 mm_tile(const bf16_t* A, int lda, const bf16_t* Bt, int ldb, int mt, int nt, int r, int q, f32x4 acc) {
#pragma unroll
    for (int ks = 0; ks < 2; ++ks) {
        const bf16x8 a = *(const bf16x8*)(A + (mt * 16 + r) * lda + ks * 32 + q * 8);
        const bf16x8 b = *(const bf16x8*)(Bt + (nt * 16 + r) * ldb + ks * 32 + q * 8);
        acc = MFMA16(a, b, acc);
    }
    return acc;
}
#define LBAR() do { asm volatile("s_waitcnt lgkmcnt(0)" ::: "memory"); __builtin_amdgcn_s_barrier(); asm volatile("" ::: "memory"); } while (0)
struct FED { unsigned dd[4], id[4]; };
struct Frag2 { bf16x8 k0, k1; };
DI Frag2 ldf(const bf16_t* M, int ld, int tile, int r, int q) { Frag2 f; const bf16_t* p = M + (tile * 16 + r) * ld + q * 8; f.k0 = *(const bf16x8*)p; f.k1 = *(const bf16x8*)(p + 32); return f; }
DI Frag2 ldf_gs(const bf16_t* M, int tile, int r, int q) {
    Frag2 f; const int row = tile * 16 + r; const bf16_t* p = M + row * 64; const int sw = (row >> 1) & 7;
    f.k0 = *(const bf16x8*)(p + ((q ^ sw) * 8)); f.k1 = *(const bf16x8*)(p + (((4 + q) ^ sw) * 8)); return f; }
DI f32x4 mmf(const Frag2& a, const Frag2& b, f32x4 acc) { acc = MFMA16(a.k0, b.k0, acc); return MFMA16(a.k1, b.k1, acc); }
#define SCHED_FENCE() __builtin_amdgcn_sched_barrier(0)
#define Z4 ((f32x4){0.f, 0.f, 0.f, 0.f})
DI void fe_dir_load(const Params& P, int l, int b, int tc, int d, FED& o) {
    const int c = otid() & 63, g = __builtin_amdgcn_readfirstlane(otid() >> 6), t0 = tc * 64 + 8 * g;
    const bf16_t* ua = (const bf16_t*)(P.ws() + WS_UA) + (size_t)b * T_ * UA_LD;
    const float* mu = P.in(I_MU) + l * 2304;
    const int cd = 2048 + d * 64 + c, ci = 2048 + 128 + d * 64 + c;
    float td[8], ti[8];
    load_shift8(ua, t0, cd, mu[cd], td); load_shift8(ua, t0, ci, mu[ci], ti);
#pragma unroll
    for (int e = 0; e < 4; ++e) { o.dd[e] = pk2(2.f * sigm(2.f * td[2 * e]) - 1.f, 2.f * sigm(2.f * td[2 * e + 1]) - 1.f); o.id[e] = pk2(ti[2 * e], ti[2 * e + 1]); }
}
DI void fe_shared(const Params& P, int l, int b, int h, int tc, FE& f) {
    const int c = otid() & 63, g = __builtin_amdgcn_readfirstlane(otid() >> 6), t0 = tc * 64 + 8 * g, ch = h * 64 + c;
    const bf16_t* ua = (const bf16_t*)(P.ws() + WS_UA) + (size_t)b * T_ * UA_LD;
    const float* mu = P.in(I_MU) + l * 2304;
    load_shift8(ua, t0, ch, mu[ch], f.r); load_shift8(ua, t0, 512 + ch, mu[512 + ch], f.k);
    load_shift8(ua, t0, 1024 + ch, mu[1024 + ch], f.v); load_shift8(ua, t0, 1536 + ch, mu[1536 + ch], f.z);
    if (l > 0) {
        const float v0 = P.in(I_V0)[(l - 1) * 512 + ch]; const bf16_t* VF = (const bf16_t*)(P.ws() + WS_VF);
#pragma unroll
        for (int e = 0; e < 8; ++e) {
            const int tok = t0 + e; const float mix = sigm(v0 + ldbf(ua, ((unsigned)tok * UA_LD + 2304u + (unsigned)ch) * 2u));
            const float vf = ldbf(VF, (((unsigned)b * T_ + (unsigned)tok) * 512u + (unsigned)ch) * 2u); f.v[e] += (vf - f.v[e]) * mix;
        }
    }
    const float kkc = P.in(I_KK)[l * 512 + ch];
#pragma unroll
    for (int e = 0; e < 8; ++e) f.kk[e] = f.k[e] * kkc;
    {
        float ss[8];
#pragma unroll
        for (int e = 0; e < 8; ++e) ss[e] = f.kk[e] * f.kk[e];
        wave_sum8(ss);
#pragma unroll
        for (int e = 0; e < 8; ++e) f.kk[e] *= rsqrtf(fmaxf(ss[e], 1e-24f));
    }
}
constexpr int OFF_DLS = 144128;
DI void fe_dir(const Params& P, int l, int b, int h, int tc, int d, const FE& f, const FED& fd, float (&ksum)[8], unsigned char* smem, bool store_s2, u32x4& btw) {
    const int tid = otid(), c = tid & 63, g = __builtin_amdgcn_readfirstlane(tid >> 6), ch = h * 64 + c, r = c & 15, q = c >> 4;
    bf16_t* DDs = (bf16_t*)(smem + OFF_DD); bf16_t* IDs = (bf16_t*)(smem + OFF_ID); float* WRs = (float*)(smem + OFF_WR); float* ARs = (float*)(smem + OFF_AR);
    bf16_t* Rs = (bf16_t*)(smem + OFF_R); bf16_t* As = (bf16_t*)(smem + OFF_A); bf16_t* Bs = (bf16_t*)(smem + OFF_B); bf16_t* Ks = (bf16_t*)(smem + OFF_K);
    bf16_t* ATs = (bf16_t*)(smem + OFF_AT); bf16_t* KTs = (bf16_t*)(smem + OFF_KT); bf16_t* VTs = (bf16_t*)(smem + OFF_VT); float* GS = (float*)(smem + OFF_GS);
    const float w0 = P.in(I_W0)[(l * 2 + d) * 512 + ch], a0 = P.in(I_A0)[(l * 2 + d) * 512 + ch], ka = P.in(I_KA)[l * 512 + ch];
    bf16x8 bfr[4][2];
    {
        const bf16_t* upT = (const bf16_t*)(P.ws() + WS_UPT);
#pragma unroll
        for (int e = 0; e < 4; ++e) {
            const int ti = g * 4 + e, which = ti >> 4, nt = ti & 3;
            const bf16_t* Bt = upT + (size_t)(which * 2 + d) * 512 * 64 + (size_t)(h * 64) * 64;
#pragma unroll
            for (int ks = 0; ks < 2; ++ks) bfr[e][ks] = *(const bf16x8*)(Bt + (nt * 16 + r) * 64 + ks * 32 + q * 8);
        }
    }
#pragma unroll
    for (int e = 0; e < 4; ++e) { DDs[(8 * g + 2 * e) * LP + c] = (bf16_t)(fd.dd[e] & 0xffffu); DDs[(8 * g + 2 * e + 1) * LP + c] = (bf16_t)(fd.dd[e] >> 16);
                                  IDs[(8 * g + 2 * e) * LP + c] = (bf16_t)(fd.id[e] & 0xffffu); IDs[(8 * g + 2 * e + 1) * LP + c] = (bf16_t)(fd.id[e] >> 16); }
    LBAR();
    {
        const int which = g >> 2, mt = g & 3;
        const Frag2 a = ldf(which ? IDs : DDs, LP, mt, r, q);
        float* O = which ? ARs : WRs;
#pragma unroll
        for (int e = 0; e < 4; ++e) {
            f32x4 acc = MFMA16(a.k0, bfr[e][0], Z4); acc = MFMA16(a.k1, bfr[e][1], acc);
#pragma unroll
            for (int j = 0; j < 4; ++j) O[(mt * 16 + 4 * q + j) * 65 + e * 16 + r] = acc[j];
        }
    }
    LBAR();
    float lw[8], av[8], cl[8];
#pragma unroll
    for (int e = 0; e < 8; ++e) {
        const int i = 8 * g + e; const float x = -(w0 + WRs[i * 65 + c]);
        const float sp = fmaxf(x, 0.f) + __logf(1.f + __expf(-fabsf(x)));
        lw[e] = -__expf(-sp - 0.5f); av[e] = sigm(a0 + ARs[i * 65 + c]);
    }
    float s = 0.f;
    if (d == 0) {
#pragma unroll
        for (int e = 0; e < 8; ++e) { s += lw[e]; cl[e] = s; }
    } else {
#pragma unroll
        for (int e = 7; e >= 0; --e) { s += lw[e]; cl[e] = s; }
    }
    GS[g * 64 + c] = s;
    LBAR();
    float off = 0.f, tot = 0.f;
#pragma unroll
    for (int gg = 0; gg < 8; ++gg) { const float x = GS[gg * 64 + c]; tot += x; if (d == 0 ? (gg < g) : (gg > g)) off += x; }
    const int pstart = d ? (56 - 8 * g) : 8 * g;
    unsigned pa[4], pb[4], pk[4], pv[4];
#pragma unroll
    for (int e2 = 0; e2 < 4; ++e2) {
        float Av2[2], Bv2[2], Kv2[2];
#pragma unroll
        for (int u = 0; u < 2; ++u) {
            const int e = 2 * e2 + u;
            const float cs = off + cl[e];
            const float ecs = store_s2 ? 0.f : __expf(cs), encs = __expf(-cs), eprev = store_s2 ? __expf(cs - lw[e]) : 0.f;
            const float kd = f.k[e] * (1.f + (av[e] - 1.f) * ka), bd = f.kk[e] * av[e];
            const float Rv = f.r[e] * ecs, Av = -f.kk[e] * eprev, Bv = bd * encs, Kv = kd * encs;
            const int p = d ? 63 - (8 * g + e) : 8 * g + e;
            if (!store_s2) Rs[p * LP + c] = f2bf(Rv); else As[p * LP + c] = f2bf(Av);
            Bs[p * LP + c] = f2bf(Bv); Ks[p * LP + c] = f2bf(Kv);
            ksum[e] += kd;
            Av2[u] = Av; Bv2[u] = Bv; Kv2[u] = Kv;
        }
        { const unsigned wa = pk2(Av2[0], Av2[1]), wb = pk2(Bv2[0], Bv2[1]), wk = pk2(Kv2[0], Kv2[1]), wv = pk2(f.v[2 * e2], f.v[2 * e2 + 1]);
          pa[e2] = d ? __builtin_amdgcn_alignbit(wa, wa, 16) : wa; pb[e2] = d ? __builtin_amdgcn_alignbit(wb, wb, 16) : wb;
          pk[e2] = d ? __builtin_amdgcn_alignbit(wk, wk, 16) : wk; pv[e2] = d ? __builtin_amdgcn_alignbit(wv, wv, 16) : wv; }
    }
    {
        u32x4 w;
        if (store_s2) {
        w.x = d ? pa[3] : pa[0]; w.y = d ? pa[2] : pa[1]; w.z = d ? pa[1] : pa[2]; w.w = d ? pa[0] : pa[3]; *(u32x4*)(ATs + c * LP + pstart) = w;
        w.x = d ? pk[3] : pk[0]; w.y = d ? pk[2] : pk[1]; w.z = d ? pk[1] : pk[2]; w.w = d ? pk[0] : pk[3]; *(u32x4*)(KTs + c * LP + pstart) = w;
        }
        w.x = d ? pv[3] : pv[0]; w.y = d ? pv[2] : pv[1]; w.z = d ? pv[1] : pv[2]; w.w = d ? pv[0] : pv[3]; *(u32x4*)(VTs + c * LP + pstart) = w;
        if (store_s2) {
            btw.x = d ? pb[3] : pb[0]; btw.y = d ? pb[2] : pb[1]; btw.z = d ? pb[1] : pb[2]; btw.w = d ? pb[0] : pb[3];
            if (g == 0) ((float*)(smem + OFF_DLS))[c] = __expf(tot);
        }
    }
    LBAR();
}
DI void tile_out(const bf16_t* src, bf16_t* dst) { const int t = otid(), row = t >> 3, seg = t & 7; *(u32x4*)(dst + row * 64 + ((seg ^ ((row >> 1) & 7)) * 8)) = *(const u32x4*)(src + row * LP + seg * 8); }

DI void s1_phase(const Params& P, int l, unsigned char* smem) {
    const int tid = otid(), lane = tid & 63, w = __builtin_amdgcn_readfirstlane(tid >> 6), r = lane & 15, q = lane >> 4;
    bf16_t* Rs = (bf16_t*)(smem + OFF_R); bf16_t* As = (bf16_t*)(smem + OFF_A); bf16_t* Bs = (bf16_t*)(smem + OFF_B); bf16_t* Ks = (bf16_t*)(smem + OFF_K);
    bf16_t* ATs = (bf16_t*)(smem + OFF_AT); bf16_t* KTs = (bf16_t*)(smem + OFF_KT); bf16_t* VTs = (bf16_t*)(smem + OFF_VT);
    bf16_t* MAKs = (bf16_t*)(smem + OFF_MAK);
    bf16_t* PB[2] = {(bf16_t*)(smem + OFF_P), (bf16_t*)(smem + OFF_YS)};
    bf16_t* PTB[2] = {(bf16_t*)(smem + OFF_PT), Rs};
    bf16_t* TB_[2] = {(bf16_t*)(smem + OFF_T), (bf16_t*)(smem + OFF_GS + 16640 + 2048)};
    for (int item = obid(); item < 2048; item += gridDim.x) {
        const int h = (item >> 3) & 7, tci = (item & 7) + 8 * ((item >> 6) & 3) + 32 * (item >> 8), tc = tci & 127, b = tci >> 7;
        FE f; FED fd0, fd1; float ksum[8];
#pragma unroll
        for (int e = 0; e < 8; ++e) ksum[e] = 0.f;
        fe_dir_load(P, l, b, tc, 0, fd0); fe_dir_load(P, l, b, tc, 1, fd1);
        fe_shared(P, l, b, h, tc, f);
#pragma unroll
        for (int d = 0; d < 2; ++d) {
        FED fd;
#pragma unroll
        for (int e = 0; e < 4; ++e) { fd.dd[e] = fd0.dd[e]; fd.id[e] = fd0.id[e]; }
        u32x4 btw;
        fe_dir(P, l, b, h, tc, d, f, fd, ksum, smem, true, btw);
        const int which = w >> 2, mtw = w & 3;
        f32x4 macc[4];
        {
            const Frag2 a = ldf(As, LP, mtw, r, q); Frag2 bb[4];
#pragma unroll
            for (int e = 0; e < 4; ++e) bb[e] = ldf(which ? Ks : Bs, LP, e, r, q);
            SCHED_FENCE();
#pragma unroll
            for (int e = 0; e < 4; ++e) macc[e] = mmf(a, bb[e], Z4);
        }
#pragma unroll
        for (int e = 0; e < 4; ++e) {
            const int mt = mtw, nt = e; const f32x4 acc = macc[e];
#pragma unroll
            for (int j = 0; j < 4; ++j) {
                const int m = mt * 16 + 4 * q + j, n = nt * 16 + r; const float v = (n < m) ? acc[j] : 0.f;
                if (which) MAKs[m * LP + n] = f2bf(v);
                else { const bf16_t hv = f2bf(v); PB[0][m * LP + n] = hv; PTB[0][n * LP + m] = hv; TB_[0][m * LP + n] = f2bf(v + (m == n ? 1.f : 0.f)); }
            }
        }
        LBAR();
        const int mt2 = w >> 1, nt2 = (w & 1) * 2;
#define WRITE_P(SET, PN) do { _Pragma("unroll") for (int e = 0; e < 2; ++e) { const int nt = nt2 + e; \
            _Pragma("unroll") for (int j = 0; j < 4; ++j) PB[SET][(mt2 * 16 + 4 * q + j) * LP + nt * 16 + r] = f2bf(PN[e][j]); \
            u32x2 t2; t2.x = pk2(PN[e][0], PN[e][1]); t2.y = pk2(PN[e][2], PN[e][3]); *(u32x2*)(PTB[SET] + (nt * 16 + r) * LP + mt2 * 16 + 4 * q) = t2; } } while (0)
#define WRITE_T(SET, TN) do { _Pragma("unroll") for (int e = 0; e < 2; ++e) { _Pragma("unroll") for (int j = 0; j < 4; ++j) TB_[SET][(mt2 * 16 + 4 * q + j) * LP + (nt2 + e) * 16 + r] = f2bf(TN[e][j]); } } while (0)
        {
            f32x4 pn2[2];
            { const Frag2 a = ldf(PB[0], LP, mt2, r, q), b0 = ldf(PTB[0], LP, nt2, r, q), b1 = ldf(PTB[0], LP, nt2 + 1, r, q);
              SCHED_FENCE();
              pn2[0] = mmf(a, b0, Z4); pn2[1] = mmf(a, b1, Z4); }
            WRITE_P(1, pn2);
        }
        LBAR();
#pragma unroll
        for (int it = 1; it <= 5; ++it) {
            const int pc = it & 1, tc = (it - 1) & 1;
            f32x4 pn2[2], tn2[2];
            { const Frag2 ap = ldf(PB[pc], LP, mt2, r, q), at = ldf(TB_[tc], LP, mt2, r, q), b0 = ldf(PTB[pc], LP, nt2, r, q), b1 = ldf(PTB[pc], LP, nt2 + 1, r, q);
              f32x4 i0, i1;
#pragma unroll
              for (int j = 0; j < 4; ++j) { i0[j] = bf2f(TB_[tc][(mt2 * 16 + 4 * q + j) * LP + nt2 * 16 + r]); i1[j] = bf2f(TB_[tc][(mt2 * 16 + 4 * q + j) * LP + (nt2 + 1) * 16 + r]); }
              SCHED_FENCE();
              tn2[0] = mmf(at, b0, i0); tn2[1] = mmf(at, b1, i1);
              if (it < 5) { pn2[0] = mmf(ap, b0, Z4); pn2[1] = mmf(ap, b1, Z4); } }
            if (it < 5) WRITE_P(pc ^ 1, pn2);
            WRITE_T(tc ^ 1, tn2);
            LBAR();
        }
#undef WRITE_P
#undef WRITE_T
        bf16_t* Ts = TB_[1];
        bf16_t* XTs = (bf16_t*)(smem + OFF_P);
        bf16_t* BTs = (bf16_t*)(smem + OFF_PT); bf16_t* AHTs = (bf16_t*)(smem + OFF_T);
        bf16_t* OUTA = Bs; bf16_t* OUTU = As; bf16_t* OUTV = Ks; bf16_t* OUTC = ATs;
        const float* DLs = (const float*)(smem + OFF_DLS);
        { const int c = lane, pstart = d ? (56 - 8 * w) : 8 * w; *(u32x4*)(BTs + c * LP + pstart) = btw; }
        f32x4 xo2[2], ah2[2], vk2[2];
        { const Frag2 av = ldf(VTs, LP, mt2, r, q), at = ldf(Ts, LP, mt2, r, q);
          Frag2 bm[2], ba[2], bk[2];
#pragma unroll
          for (int e = 0; e < 2; ++e) { bm[e] = ldf(MAKs, LP, nt2 + e, r, q); ba[e] = ldf(ATs, LP, nt2 + e, r, q); bk[e] = ldf(KTs, LP, nt2 + e, r, q); }
          SCHED_FENCE();
#pragma unroll
          for (int e = 0; e < 2; ++e) { xo2[e] = mmf(av, bm[e], Z4); ah2[e] = mmf(at, ba[e], Z4); vk2[e] = mmf(av, bk[e], Z4); } }
#pragma unroll
        for (int e = 0; e < 2; ++e) { const int mt = mt2, nt = nt2 + e; const f32x4 x = xo2[e], ah = ah2[e], vk = vk2[e];
#pragma unroll
            for (int j = 0; j < 4; ++j) { const int o = (mt * 16 + 4 * q + j) * LP + nt * 16 + r; XTs[o] = f2bf(x[j]); OUTA[o] = f2bf(ah[j]); OUTV[o] = f2bf(vk[j]); }
            u32x2 t2; t2.x = pk2(ah[0], ah[1]); t2.y = pk2(ah[2], ah[3]); *(u32x2*)(AHTs + (nt * 16 + r) * LP + mt * 16 + 4 * q) = t2; }
        LBAR();
        f32x4 u02[2];
        { const Frag2 a = ldf(XTs, LP, mt2, r, q), b0 = ldf(Ts, LP, nt2, r, q), b1 = ldf(Ts, LP, nt2 + 1, r, q);
          SCHED_FENCE();
          u02[0] = mmf(a, b0, Z4); u02[1] = mmf(a, b1, Z4); }
#pragma unroll
        for (int e = 0; e < 2; ++e) { const int mt = mt2, nt = nt2 + e; const f32x4 u0 = u02[e];
#pragma unroll
            for (int j = 0; j < 4; ++j) OUTU[(mt * 16 + 4 * q + j) * LP + nt * 16 + r] = f2bf(u0[j]); }
        LBAR();
        f32x4 ac2[2], bc2[2]; float dlc2[2], dlm[4];
        { const Frag2 a1 = ldf(BTs, LP, mt2, r, q), a2 = ldf(OUTU, LP, mt2, r, q);
          Frag2 b1[2], b2[2]; f32x4 vk0[2];
#pragma unroll
          for (int e = 0; e < 2; ++e) { b1[e] = ldf(AHTs, LP, nt2 + e, r, q); b2[e] = ldf(BTs, LP, nt2 + e, r, q); dlc2[e] = DLs[(nt2 + e) * 16 + r];
#pragma unroll
              for (int j = 0; j < 4; ++j) vk0[e][j] = bf2f(OUTV[(mt2 * 16 + 4 * q + j) * LP + (nt2 + e) * 16 + r]); }
#pragma unroll
          for (int j = 0; j < 4; ++j) dlm[j] = DLs[mt2 * 16 + 4 * q + j];
          SCHED_FENCE();
#pragma unroll
          for (int e = 0; e < 2; ++e) { ac2[e] = mmf(a1, b1[e], Z4); bc2[e] = mmf(a2, b2[e], vk0[e]); } }
#pragma unroll
        for (int e = 0; e < 2; ++e) { const int mt = mt2, nt = nt2 + e; const f32x4 ac = ac2[e], bc = bc2[e];
            const float dlc = dlc2[e];
#pragma unroll
            for (int j = 0; j < 4; ++j) { const int m = mt * 16 + 4 * q + j, n = nt * 16 + r;
                OUTC[m * LP + n] = f2bf((ac[j] + (m == n ? 1.f : 0.f)) * dlm[j]); OUTV[m * LP + n] = f2bf(bc[j] * dlc); } }
        LBAR();
        {
            const int dh = d * 8 + h, pc = d ? 127 - tc : tc; const size_t base = ((size_t)(dh * 128 + pc)) * 4096;
            unsigned char* sc = P.scb(b); tile_out(OUTA, (bf16_t*)(sc + SC_AH) + base); tile_out(OUTU, (bf16_t*)(sc + SC_U0) + base);
            tile_out(OUTC, (bf16_t*)(sc + SC_BT) + base); tile_out(OUTV, (bf16_t*)(sc + SC_VK) + base);
        }
        LBAR();
#pragma unroll
        for (int e = 0; e < 4; ++e) { fd0.dd[e] = fd1.dd[e]; fd0.id[e] = fd1.id[e]; }
        }
    }
}

constexpr int S2_SLOT = 10240, S2_NS = 12, S2_D = 8, S2_G = 4;
DI bf16x8 mk8(u32x2 lo, u32x2 hi) { u32x4 v; v.x = lo.x; v.y = lo.y; v.z = hi.x; v.w = hi.y; return __builtin_bit_cast(bf16x8, v); }
DI void s2_issue(const unsigned char* sc, int dh, int vg, int pc, int w, int lane, unsigned char* smem) {
    const size_t cb = ((size_t)(dh * 128 + pc)) * 8192;
    PG8_LAS unsigned char* slot = (PG8_LAS unsigned char*)smem + (pc % S2_NS) * S2_SLOT;
#pragma unroll
    for (int i = 0; i < 2; ++i) {
        const int piece = 2 * (w - 1) + i;
        const unsigned char* g = (piece < 8) ? sc + SC_BT + cb + piece * 1024 : sc + SC_VK + cb + vg * 2048 + (piece - 8) * 1024;
        __builtin_amdgcn_global_load_lds((const unsigned*)(g + lane * 16), (PG8_LAS unsigned*)(slot + piece * 1024), 16, 0, 0);
    }
}
DI void s2_phase(const Params& P, unsigned char* smem) {
    if (obid() >= 128) return;
    const int bid = obid(), tid = otid(), bdh = (bid & 7) + 8 * (bid >> 5), b = bdh >> 4, dh = bdh & 15, vg = (bid >> 3) & 3,     lane = tid & 63, r = lane & 15, q = lane >> 4, w = __builtin_amdgcn_readfirstlane(tid >> 6);
    unsigned char* sc = P.scb(b);
    const bool loader = (w >= 1 && w <= 5);
    __syncthreads();
    if (loader) {
        for (int c = 0; c < S2_D; ++c) s2_issue(sc, dh, vg, c, w, lane, smem);
        asm volatile("s_waitcnt vmcnt(8)" ::: "memory");
    }
    __syncthreads();
    f32x4 S[4];
#pragma unroll
    for (int t = 0; t < 4; ++t) S[t] = (f32x4){0.f, 0.f, 0.f, 0.f};
    const int sw = (r >> 1) & 7;
    int xo[2][2], yo[4];
#pragma unroll
    for (int ks = 0; ks < 2; ++ks)
#pragma unroll
        for (int hi = 0; hi < 2; ++hi) xo[ks][hi] = r * 128 + (q & 1) * 8 + (((4 * ks + 2 * hi + (q >> 1)) ^ sw) << 4);
#pragma unroll
    for (int t = 0; t < 4; ++t) yo[t] = r * 128 + (q & 1) * 8 + (((2 * t + (q >> 1)) ^ sw) << 4);
    const int go = (16 * vg + r) * 64 + (q & 1) * 4;
#pragma unroll 1
    for (int pc = 0; pc < 128; pc += S2_G) {
        if (loader) {
            if (pc + S2_D < 128) {
#pragma unroll
                for (int c = 0; c < S2_G; ++c) s2_issue(sc, dh, vg, pc + S2_D + c, w, lane, smem);
                asm volatile("s_waitcnt vmcnt(8)" ::: "memory");
            }
            else asm volatile("s_waitcnt vmcnt(0)" ::: "memory");
        } else if (w == 0) {
            u32x2 fa[S2_G][4][2][2], fv[S2_G][4];
#pragma unroll
            for (int c2 = 0; c2 < S2_G; ++c2) {
                const unsigned char* sl = smem + ((pc + c2) % S2_NS) * S2_SLOT;
#pragma unroll
                for (int t = 0; t < 4; ++t) {
#pragma unroll
                    for (int ks = 0; ks < 2; ++ks)
#pragma unroll
                        for (int hi = 0; hi < 2; ++hi) fa[c2][t][ks][hi] = *(const u32x2*)(sl + t * 2048 + xo[ks][hi]);
                    fv[c2][t] = *(const u32x2*)(sl + 8192 + yo[t]);
                }
            }
#pragma unroll
            for (int c2 = 0; c2 < S2_G; ++c2) {
                bf16_t* S0g = (bf16_t*)(sc + SC_VK) + ((size_t)(dh * 128 + pc + c2)) * 4096;
                u32x2 sb[4];
#pragma unroll
                for (int t = 0; t < 4; ++t) { sb[t].x = pk2(S[t][0], S[t][1]); sb[t].y = pk2(S[t][2], S[t][3]); }
#pragma unroll
                for (int t = 0; t < 4; ++t) {
                    f32x4 a = (f32x4){bflo(fv[c2][t].x), bfhi(fv[c2][t].x), bflo(fv[c2][t].y), bfhi(fv[c2][t].y)};
#pragma unroll
                    for (int ks = 0; ks < 2; ++ks) a = MFMA16(mk8(fa[c2][t][ks][0], fa[c2][t][ks][1]), mk8(sb[2 * ks], sb[2 * ks + 1]), a);
                    S[t] = a;
                }
#pragma unroll
                for (int t = 0; t < 4; ++t) *(u32x2*)(S0g + go + (((2 * t + (q >> 1)) ^ sw) << 3)) = sb[t];
            }
        }
        asm volatile("" ::: "memory"); __builtin_amdgcn_s_barrier(); asm volatile("" ::: "memory");
    }
    asm volatile("s_waitcnt vmcnt(0) lgkmcnt(0)" ::: "memory");
    __syncthreads();
}

struct RAW3 { unsigned u[6][10]; float mu[6]; float kkc; };
DI unsigned raw16(const bf16_t* base, unsigned byteoff) { return *(const bf16_t*)((const unsigned char*)base + byteoff); }
DI void raw3_issue(const Params& P, int l, int item, RAW3& R) {
    const int h = (item >> 3) & 7, tci = (item & 7) + 8 * ((item >> 6) & 3) + 32 * (item >> 8), tc = tci & 127, b = tci >> 7;
    const int c = otid() & 63, g = __builtin_amdgcn_readfirstlane(otid() >> 6), t0 = tc * 64 + 8 * g, ch = h * 64 + c;
    const bf16_t* ua = (const bf16_t*)(P.ws() + WS_UA) + (size_t)b * T_ * UA_LD;
    const float* mu = P.in(I_MU) + l * 2304;
    const int tlo = t0 > 0 ? t0 - 1 : 0, thi = t0 + 8 < T_ ? t0 + 8 : T_ - 1;
    const int cols[6] = {ch, 512 + ch, 1024 + ch, 1536 + ch, 2048 + c, 2048 + 128 + c};
#pragma unroll
    for (int gi = 0; gi < 6; ++gi) {
        const unsigned col = (unsigned)cols[gi], o0 = ((unsigned)t0 * UA_LD + col) * 2u;
        R.u[gi][0] = raw16(ua, ((unsigned)tlo * UA_LD + col) * 2u); R.u[gi][9] = raw16(ua, ((unsigned)thi * UA_LD + col) * 2u);
#pragma unroll
        for (int e = 0; e < 8; ++e) R.u[gi][e + 1] = raw16(ua, o0 + (unsigned)e * (UA_LD * 2u));
        R.mu[gi] = mu[col];
    }
    R.kkc = P.in(I_KK)[l * 512 + ch];
}
DI void raw3_shift(const RAW3& R, int gi, int t0, float (&out)[8]) {
    float u[10];
#pragma unroll
    for (int e = 0; e < 10; ++e) u[e] = __uint_as_float(R.u[gi][e] << 16);
    u[0] = t0 > 0 ? u[0] : 0.f; u[9] = t0 + 8 < T_ ? u[9] : 0.f;
#pragma unroll
    for (int e = 0; e < 8; ++e) out[e] = u[e + 1] + R.mu[gi] * (0.5f * (u[e] + u[e + 2]) - u[e + 1]);
}
DI void raw3_consume(const Params& P, const RAW3& R, int l, int b, int h, int tc, FE& f, FED& fd0) {
    const int g = __builtin_amdgcn_readfirstlane(otid() >> 6), t0 = tc * 64 + 8 * g;
    raw3_shift(R, 0, t0, f.r); raw3_shift(R, 1, t0, f.k); raw3_shift(R, 2, t0, f.v); raw3_shift(R, 3, t0, f.z);
    {
        float td[8], ti[8];
        raw3_shift(R, 4, t0, td); raw3_shift(R, 5, t0, ti);
#pragma unroll
        for (int e = 0; e < 4; ++e) { fd0.dd[e] = pk2(2.f * sigm(2.f * td[2 * e]) - 1.f, 2.f * sigm(2.f * td[2 * e + 1]) - 1.f); fd0.id[e] = pk2(ti[2 * e], ti[2 * e + 1]); }
    }
    if (l > 0) {
        const int c = otid() & 63, ch = h * 64 + c;
        const bf16_t* ua = (const bf16_t*)(P.ws() + WS_UA) + (size_t)b * T_ * UA_LD; const bf16_t* VF = (const bf16_t*)(P.ws() + WS_VF);
        const float v0 = P.in(I_V0)[(l - 1) * 512 + ch];
#pragma unroll
        for (int e = 0; e < 8; ++e) {
            const unsigned tok = (unsigned)(t0 + e); const float mix = sigm(v0 + ldbf(ua, (tok * UA_LD + 2304u + (unsigned)ch) * 2u));
            const float vf = ldbf(VF, (((unsigned)b * T_ + tok) * 512u + (unsigned)ch) * 2u); f.v[e] += (vf - f.v[e]) * mix;
        }
    }
#pragma unroll
    for (int e = 0; e < 8; ++e) f.kk[e] = f.k[e] * R.kkc;
    {
        float ss[8];
#pragma unroll
        for (int e = 0; e < 8; ++e) ss[e] = f.kk[e] * f.kk[e];
        wave_sum8(ss);
#pragma unroll
        for (int e = 0; e < 8; ++e) f.kk[e] *= rsqrtf(fmaxf(ss[e], 1e-24f));
    }
}

DI void s3_phase(const Params& P, int l, unsigned char* smem) {
    const int tid = otid(), lane = tid & 63, w = __builtin_amdgcn_readfirstlane(tid >> 6), r = lane & 15, q = lane >> 4;
    bf16_t* Rs = (bf16_t*)(smem + OFF_R); bf16_t* Bs = (bf16_t*)(smem + OFF_B); bf16_t* Ks = (bf16_t*)(smem + OFF_K); bf16_t* VTs = (bf16_t*)(smem + OFF_VT);
    bf16_t* MRB = (bf16_t*)(smem + OFF_WR); bf16_t* MRK = (bf16_t*)(smem + OFF_AR); float* YS = (float*)(smem + OFF_YS);
    RAW3 R;
    { const int first = obid(); if (first < 2048) raw3_issue(P, l, first, R); }
    for (int item = obid(); item < 2048; item += gridDim.x) {
        const int h = (item >> 3) & 7, tci = (item & 7) + 8 * ((item >> 6) & 3) + 32 * (item >> 8), tc = tci & 127, b = tci >> 7;
        FE f; FED fd0, fd1; float ksum[8];
#pragma unroll
        for (int e = 0; e < 8; ++e) ksum[e] = 0.f;
        fe_dir_load(P, l, b, tc, 1, fd1);
        const float lnw = P.in(I_LNW)[l * 512 + h * 64 + lane], lnb = P.in(I_LNB)[l * 512 + h * 64 + lane], rk = P.in(I_RK)[l * 512 + h * 64 + lane];
        raw3_consume(P, R, l, b, h, tc, f, fd0);
#pragma unroll
        for (int d = 0; d < 2; ++d) {
            FED fd;
#pragma unroll
            for (int e = 0; e < 4; ++e) { fd.dd[e] = fd0.dd[e]; fd.id[e] = fd0.id[e]; }
            u32x4 btw;
            fe_dir(P, l, b, h, tc, d, f, fd, ksum, smem, false, btw);
            if (d == 1 && item + (int)gridDim.x < 2048) raw3_issue(P, l, item + (int)gridDim.x, R);
            const int which = w >> 2, mtw = w & 3, mt2 = w >> 1, nt2 = (w & 1) * 2;
            const int dh = d * 8 + h, pc = d ? 127 - tc : tc; const size_t base = ((size_t)(dh * 128 + pc)) * 4096;
            const bf16_t* U0T = (const bf16_t*)(P.scb(b) + SC_U0) + base; const bf16_t* S0 = (const bf16_t*)(P.scb(b) + SC_VK) + base; const bf16_t* AH = (const bf16_t*)(P.scb(b) + SC_AH) + base;
            const Frag2 gah = ldf_gs(AH, mt2, r, q), gs0 = ldf_gs(S0, nt2, r, q), gs1 = ldf_gs(S0, nt2 + 1, r, q);
            u32x2 gu0[2];
#pragma unroll
            for (int e = 0; e < 2; ++e) { const int vrow = (nt2 + e) * 16 + r; gu0[e] = *(const u32x2*)(U0T + vrow * 64 + (((2 * mt2 + (q >> 1)) ^ ((vrow >> 1) & 7)) << 3) + (q & 1) * 4); }
            f32x4 macc[4];
            { const Frag2 a = ldf(Rs, LP, mtw, r, q); Frag2 bb[4];
#pragma unroll
              for (int e = 0; e < 4; ++e) bb[e] = ldf(which ? Ks : Bs, LP, e, r, q);
              SCHED_FENCE();
#pragma unroll
              for (int e = 0; e < 4; ++e) macc[e] = mmf(a, bb[e], Z4); }
#pragma unroll
            for (int e = 0; e < 4; ++e) {
                const int mt = mtw, nt = e; const f32x4 acc = macc[e];
                bf16_t* O = which ? MRK : MRB;
#pragma unroll
                for (int j = 0; j < 4; ++j) { const int m = mt * 16 + 4 * q + j, n = nt * 16 + r; O[m * LP + n] = f2bf((n <= m) ? acc[j] : 0.f); }
            }
            bf16_t* UTs = (bf16_t*)(smem + OFF_AT);
#pragma unroll
            for (int e = 0; e < 2; ++e) {
                const f32x4 u = mmf(gah, e ? gs1 : gs0, (f32x4){bflo(gu0[e].x), bfhi(gu0[e].x), bflo(gu0[e].y), bfhi(gu0[e].y)});
                u32x2 t2; t2.x = pk2(u[0], u[1]); t2.y = pk2(u[2], u[3]); *(u32x2*)(UTs + ((nt2 + e) * 16 + r) * LP + mt2 * 16 + 4 * q) = t2;
            }
            LBAR();
            f32x4 y2[2];
            { const Frag2 a1 = ldf(MRK, LP, mt2, r, q), a2 = ldf(MRB, LP, mt2, r, q), a3 = ldf(Rs, LP, mt2, r, q);
              Frag2 b1[2], b2[2];
#pragma unroll
              for (int e = 0; e < 2; ++e) { b1[e] = ldf(VTs, LP, nt2 + e, r, q); b2[e] = ldf(UTs, LP, nt2 + e, r, q); }
              SCHED_FENCE();
#pragma unroll
              for (int e = 0; e < 2; ++e) { f32x4 y = mmf(a1, b1[e], Z4); y = mmf(a2, b2[e], y); y2[e] = mmf(a3, e ? gs1 : gs0, y); } }
#pragma unroll
            for (int e = 0; e < 2; ++e) {
                const int mt = mt2, nt = nt2 + e; const f32x4 y = y2[e];
#pragma unroll
                for (int j = 0; j < 4; ++j) { const int p = mt * 16 + 4 * q + j, v = nt * 16 + r;
                    if (d == 0) YS[p * 65 + v] = y[j]; else YS[(63 - p) * 65 + v] += y[j]; }
            }
            LBAR();
#pragma unroll
            for (int e = 0; e < 4; ++e) { fd0.dd[e] = fd1.dd[e]; fd0.id[e] = fd1.id[e]; }
        }
        {
            const int c = lane, g = w, ch = h * 64 + c;
            bf16_t* OA = (bf16_t*)(P.ws() + WS_OA); bf16_t* VF = (bf16_t*)(P.ws() + WS_VF);
            float y8[8], s1[8], s2[8], s3[8];
#pragma unroll
            for (int e = 0; e < 8; ++e) { const float y = YS[(8 * g + e) * 65 + c]; y8[e] = y; s1[e] = y; s2[e] = y * y; s3[e] = f.r[e] * ksum[e] * rk; }
            wave_sum8(s1); wave_sum8(s2); wave_sum8(s3);
#pragma unroll
            for (int e = 0; e < 8; ++e) {
                const int i = 8 * g + e; const size_t row = (size_t)b * T_ + tc * 64 + i;
                const float mean = s1[e] * (1.f / 64.f), var = fmaxf(s2[e] * (1.f / 64.f) - mean * mean, 0.f);
                const float yn = (y8[e] - mean) * rsqrtf(var + 64e-5f) * lnw + lnb;
                const float bon = s3[e] * f.v[e];
                const float z = f.z[e];
                const unsigned ob = ((unsigned)row * 512u + (unsigned)ch) * 2u;
                *(bf16_t*)((unsigned char*)OA + ob) = f2bf((yn + bon) * (z * sigm(z)));
                if (l == 0) *(bf16_t*)((unsigned char*)VF + ob) = f2bf(f.v[e]);
            }
        }
        LBAR();
    }
}

#define RLX_AGENT __ATOMIC_RELAXED, __HIP_MEMORY_SCOPE_AGENT
#define XB_TMO      128
#define XB_XCNT(j)  (256  + 64 * (j))
#define XB_XSUB(j)  (1280 + 64 * (j))
#define XB_XGEN(j)  (2304 + 64 * (j))
#define XB_TOP      3328
#define XB_TOPGEN   3392
#define XCD_BAR_WORDS 3456
#define XB_SPIN_CAP (1u << 18)

__device__ __forceinline__ unsigned xb_ld(unsigned* p)              { return __hip_atomic_load(p, __ATOMIC_RELAXED, __HIP_MEMORY_SCOPE_AGENT); }
__device__ __forceinline__ unsigned xb_add(unsigned* p, unsigned v) { return __hip_atomic_fetch_add(p, v, __ATOMIC_RELAXED, __HIP_MEMORY_SCOPE_AGENT); }
__device__ __forceinline__ unsigned xb_xcc_id() { return (unsigned)__builtin_amdgcn_s_getreg((3 << 11) | 20) & 0xFu; }
#define XB_SPIN(cond, bar) do { unsigned _sp = 0; while (cond) { __builtin_amdgcn_s_sleep(1); \
    if ((++_sp & 255u) == 0u) { if (xb_ld(&(bar)[XB_TMO])) break; if (_sp > XB_SPIN_CAP) { atomicAdd(&(bar)[XB_TMO], 1u); break; } } } } while (0)

struct XcdBarrier {
    unsigned* bar; unsigned x;
    volatile __attribute__((address_space(3))) unsigned* st;
};

__device__ __forceinline__ XcdBarrier xcd_barrier_post(unsigned* bar, volatile __attribute__((address_space(3))) unsigned* st) {
    XcdBarrier b; b.bar = bar; b.x = xb_xcc_id(); b.st = st;
    if (threadIdx.x == 0) (void)xb_add(&bar[XB_XCNT(b.x)], 1u);
    return b;
}
__device__ __forceinline__ void xcd_barrier_complete(unsigned* bar, unsigned x, unsigned& nloc, unsigned& nx) {
    const unsigned G = gridDim.x * gridDim.y * gridDim.z;
    unsigned sum, cnt, mine, sp = 0u;
    for (;;) {
        sum = 0u; cnt = 0u; mine = 0u;
#pragma unroll
        for (unsigned j = 0; j < 16; ++j) { const unsigned c = xb_ld(&bar[XB_XCNT(j)]); sum += c; cnt += (c > 0u) ? 1u : 0u; mine = (j == x) ? c : mine; }
        if (sum == G) break;
        __builtin_amdgcn_s_sleep(1);
        if ((++sp & 255u) == 0u) { if (xb_ld(&bar[XB_TMO])) break; if (sp > XB_SPIN_CAP) { atomicAdd(&bar[XB_TMO], 1u); break; } }
    }
    nloc = mine > 0u ? mine : 1u; nx = cnt > 0u ? cnt : 1u;
}

__device__ __forceinline__ void xcd_barrier(const XcdBarrier& b) {
    asm volatile("s_waitcnt vmcnt(0)" ::: "memory");
    __syncthreads();
    if (threadIdx.x == 0) {
        unsigned* bar = b.bar;
        __builtin_amdgcn_s_waitcnt(0);
        unsigned nloc = b.st[0], nx = b.st[1];
        if (nloc == 0u) { xcd_barrier_complete(bar, b.x, nloc, nx); b.st[0] = nloc; b.st[1] = nx; }
        const unsigned old = xb_add(&bar[XB_XSUB(b.x)], 1u);
        const unsigned gen = old / nloc;
        if (old + 1u == (gen + 1u) * nloc) {
            __builtin_amdgcn_fence(__ATOMIC_RELEASE, "agent");
            asm volatile("s_waitcnt vmcnt(0)" ::: "memory");
            const unsigned og = xb_add(&bar[XB_TOP], 1u);
            const unsigned tg = og / nx;
            if (og + 1u == (tg + 1u) * nx) xb_add(&bar[XB_TOPGEN], 1u);
            else XB_SPIN(xb_ld(&bar[XB_TOPGEN]) == tg, bar);
            __builtin_amdgcn_fence(__ATOMIC_ACQUIRE, "agent");
            xb_add(&bar[XB_XGEN(b.x)], 1u);
            asm volatile("s_waitcnt vmcnt(0)" ::: "memory");
        } else {
            XB_SPIN(xb_ld(&bar[XB_XGEN(b.x)]) == gen, bar);
            __builtin_amdgcn_fence(__ATOMIC_ACQUIRE, "agent");
            asm volatile("s_waitcnt vmcnt(0)" ::: "memory");
        }
    }
    __syncthreads();
}

DI void gbar(unsigned* ctr, unsigned target) {
    asm volatile("s_waitcnt vmcnt(0)" ::: "memory");
    __syncthreads();
    if (threadIdx.x == 0) {
        __builtin_amdgcn_fence(__ATOMIC_RELEASE, "agent");
        asm volatile("s_waitcnt vmcnt(0)" ::: "memory");
        __hip_atomic_fetch_add(ctr, 1u, __ATOMIC_RELAXED, __HIP_MEMORY_SCOPE_AGENT);
        while (__hip_atomic_load(ctr, __ATOMIC_RELAXED, __HIP_MEMORY_SCOPE_AGENT) < target) __builtin_amdgcn_s_sleep(1);
        __builtin_amdgcn_fence(__ATOMIC_ACQUIRE, "agent");
        asm volatile("s_waitcnt vmcnt(0)" ::: "memory");
    }
    __syncthreads();
}
__global__ void __launch_bounds__(512, 2) fwd_megakernel(KArgs KA) {
    extern __shared__ __attribute__((aligned(16))) unsigned char smem[];
    if (threadIdx.x == 0) {
        unsigned long long* pt = (unsigned long long*)(smem + PARAMS_OFF);
#pragma unroll
        for (int i = 0; i < 26; ++i) pt[i] = (unsigned long long)KA.in[i];
        pt[26] = (unsigned long long)KA.out; pt[27] = (unsigned long long)KA.ws;
    }
    __syncthreads();
    Params P{smem};
    XcdBarrier xbar;
    {
        volatile __attribute__((address_space(3))) unsigned* st = (volatile __attribute__((address_space(3))) unsigned*)((__attribute__((address_space(3))) unsigned char*)smem + PARAMS_OFF + 232);
        if (threadIdx.x == 0) { st[0] = 0u; st[1] = 0u; }
        __syncthreads();
        xbar = xcd_barrier_post((unsigned*)(KA.ws + WS_BAR), st);
    }
    unsigned bar_target = 0;
#define GSYNC() xcd_barrier(xbar)
#define WSP() unsigned char* ws = P.ws(); float* ssq = (float*)(ws + WS_SSQ); bf16_t* XB = (bf16_t*)(ws + WS_XB); (void)ssq; (void)XB
#ifndef PHMASK
#define PHMASK 0xffff
#endif
#define PH(k) if (PHMASK & (1 << (k)))
    static_assert(NLAYER == 2, "the layer program below is written out twice");
    { constexpr int l = 0;

        PH(0) p0_phase(P, l, smem, P.in(I_X), 3);
        GSYNC();
        PH(1) { WSP(); Epi<EP_U> E{ssq, (bf16_t*)(ws + WS_UA), (bf16_t*)(ws + WS_UB), nullptr, nullptr, nullptr, nullptr};
          run_gemm<EP_U>(smem, XB, (const bf16_t*)(ws + WS_WIN), l == 0 ? 3584 : 4096, 1024, E); }
        GSYNC();
        PH(2) attn_phase(P, l, smem);
        GSYNC();
        PH(3) s1_phase(P, l, smem);
        GSYNC();
        PH(4) s2_phase(P, smem);
        GSYNC();
        PH(5) s3_phase(P, l, smem);
        GSYNC();
        PH(6) { WSP(); Epi<EP_GATE> E{ssq, (bf16_t*)(ws + WS_GATES), nullptr, nullptr, nullptr, nullptr, nullptr};
          run_gemm<EP_GATE>(smem, XB, (const bf16_t*)(ws + WS_WIN) + (size_t)4096 * 1024, 2048, 1024, E); }
        PH(0) p16_phase(P, l);
        GSYNC();
        PH(7) { WSP(); static_assert(WS_OA == WS_OB + (size_t)M_ * 512 * 2 && WS_WPB == WS_WPA + (size_t)1024 * 512 * 2, "stacked operands");
          Epi<EP_PAB> E{nullptr, (bf16_t*)(ws + WS_MERGED), nullptr, (const bf16_t*)(ws + WS_GATES), nullptr, nullptr, nullptr};
          run_gemm_pair(smem, (const bf16_t*)(ws + WS_OB), (const bf16_t*)(ws + WS_WPA), E); }
        GSYNC();
        PH(9) { WSP(); Epi<EP_PLE> E{nullptr, (bf16_t*)(ws + WS_PLE), nullptr, nullptr, nullptr, nullptr, nullptr};
          run_gemm<EP_PLE>(smem, (const bf16_t*)(ws + WS_P16), (const bf16_t*)(ws + WS_WPLE), 1024, 256, E); }
        PH(10) { WSP(); Epi<EP_OUT> E{nullptr, XB, nullptr, nullptr, (l == 0) ? P.in(I_X) : nullptr, P.out(), ssq};
          run_gemm<EP_OUT>(smem, (const bf16_t*)(ws + WS_MERGED), (const bf16_t*)(ws + WS_WOUT), 1024, 1024, E); }
        GSYNC();
        PH(11) { WSP(); Epi<EP_FIN> E{ssq, XB, (bf16_t*)P.out(), (const bf16_t*)(ws + WS_PLE), nullptr, P.out(), (float*)(ws + WS_DL)};
          run_gemm<EP_FIN>(smem, XB, (const bf16_t*)(ws + WS_WGATE), 1024, 1024, E); }
        if (l + 1 < NLAYER) { PH(0) p0_phase(P, l + 1, smem, nullptr, 1); GSYNC(); }
    }
    { constexpr int l = 1;

        PH(0) p0_phase(P, l, smem, P.out(), 2);
        GSYNC();
        PH(1) { WSP(); Epi<EP_U> E{ssq, (bf16_t*)(ws + WS_UA), (bf16_t*)(ws + WS_UB), nullptr, nullptr, nullptr, nullptr};
          run_gemm<EP_U>(smem, XB, (const bf16_t*)(ws + WS_WIN), l == 0 ? 3584 : 4096, 1024, E); }
        GSYNC();
        PH(2) attn_phase(P, l, smem);
        GSYNC();
        PH(3) s1_phase(P, l, smem);
        GSYNC();
        PH(4) s2_phase(P, smem);
        GSYNC();
        PH(5) s3_phase(P, l, smem);
        GSYNC();
        PH(6) { WSP(); Epi<EP_GATE> E{ssq, (bf16_t*)(ws + WS_GATES), nullptr, nullptr, nullptr, nullptr, nullptr};
          run_gemm<EP_GATE>(smem, XB, (const bf16_t*)(ws + WS_WIN) + (size_t)4096 * 1024, 2048, 1024, E); }
        PH(0) p16_phase(P, l);
        GSYNC();
        PH(7) { WSP(); static_assert(WS_OA == WS_OB + (size_t)M_ * 512 * 2 && WS_WPB == WS_WPA + (size_t)1024 * 512 * 2, "stacked operands");
          Epi<EP_PAB> E{nullptr, (bf16_t*)(ws + WS_MERGED), nullptr, (const bf16_t*)(ws + WS_GATES), nullptr, nullptr, nullptr};
          run_gemm_pair(smem, (const bf16_t*)(ws + WS_OB), (const bf16_t*)(ws + WS_WPA), E); }
        GSYNC();
        PH(9) { WSP(); Epi<EP_PLE> E{nullptr, (bf16_t*)(ws + WS_PLE), nullptr, nullptr, nullptr, nullptr, nullptr};
          run_gemm<EP_PLE>(smem, (const bf16_t*)(ws + WS_P16), (const bf16_t*)(ws + WS_WPLE), 1024, 256, E); }
        PH(10) { WSP(); Epi<EP_OUT> E{nullptr, XB, nullptr, nullptr, (l == 0) ? P.in(I_X) : nullptr, P.out(), ssq};
          run_gemm<EP_OUT>(smem, (const bf16_t*)(ws + WS_MERGED), (const bf16_t*)(ws + WS_WOUT), 1024, 1024, E); }
        GSYNC();
        PH(11) { WSP(); Epi<EP_FIN> E{ssq, XB, nullptr, (const bf16_t*)(ws + WS_PLE), nullptr, P.out(), nullptr};
          run_gemm<EP_FIN>(smem, XB, (const bf16_t*)(ws + WS_WGATE), 1024, 1024, E); }
        if (l + 1 < NLAYER) GSYNC();
    }
}

extern "C" void kernel_launch(void* const* d_in, const int* in_sizes, int n_in, void* d_out, int out_size, void* d_ws, size_t ws_size, hipStream_t stream) {
    static int grid = 0;
    if (grid == 0) {
        if (n_in != 26 || ws_size < WS_END) { fprintf(stderr, "kernel_launch: unexpected n_in %d / ws_size %zu\n", n_in, ws_size); grid = -1; return; }
        int dev = 0, cus = 0, per_cu = 0;
        hipGetDevice(&dev); hipDeviceGetAttribute(&cus, hipDeviceAttributeMultiprocessorCount, dev);
        hipFuncSetAttribute((const void*)fwd_megakernel, hipFuncAttributeMaxDynamicSharedMemorySize, LDS_BYTES);
        hipOccupancyMaxActiveBlocksPerMultiprocessor(&per_cu, (const void*)fwd_megakernel, 512, LDS_BYTES);
        if (per_cu < 1) { fprintf(stderr, "kernel_launch: occupancy query says %d\n", per_cu); per_cu = 1; }
        if (per_cu > 1) per_cu = 1;
        grid = cus * per_cu;
    }
    if (grid < 0) return;
    KArgs p{};
    for (int i = 0; i < 26; ++i) p.in[i] = (const float*)d_in[i];
    p.out = (float*)d_out; p.ws = (unsigned char*)d_ws;
    hipMemsetAsync((unsigned char*)d_ws + WS_BAR, 0, XCD_BAR_WORDS * 4, stream);
    void* args[] = {&p};
    hipError_t e = hipLaunchCooperativeKernel((void*)fwd_megakernel, dim3(grid), dim3(512), args, LDS_BYTES, stream);
    if (e != hipSuccess) fprintf(stderr, "cooperative launch failed: %s (grid %d)\n", hipGetErrorString(e), grid);
}
```
